# Optimizing an MI355X kernel written in HIP

```python
import math
import jax, jax.numpy as jnp
from jax import lax
import numpy as np

D_MODEL = 1024
BATCH = 16
SEQ = 2048
DEPTH = 1

BLOCK = 128
EPS = 1e-6
HEAD_DIM = 64
SWA_Q_HEADS = 8
SWA_KV_HEADS = 2
SWA_WINDOW = 128
N_BUCKETS = 32
MAX_DISTANCE = 128
SB_HEADS = 8
MEM_LEN = 256
MEM_HEADS = 4
MEM_HEAD_DIM = 128
SWA_Q_W = SWA_Q_HEADS * HEAD_DIM
SWA_KV_W = SWA_KV_HEADS * HEAD_DIM
SB_W = SB_HEADS * HEAD_DIM
MEM_W = MEM_HEADS * MEM_HEAD_DIM
N_BRANCH = 3
IN_SPLITS = (SWA_Q_W, SWA_KV_W, SWA_KV_W, SB_W, SB_W, SB_W, MEM_W, N_BRANCH * D_MODEL)
IN_W = sum(IN_SPLITS)
D_FF = -(-8 * D_MODEL // (3 * 256)) * 256

kernel_name = "hybrid_gated_swa_stickbreak_memxattn_swiglu"


def rms_norm(x, g):
    xf = x.astype(jnp.float32)
    y = xf * lax.rsqrt(jnp.mean(xf * xf, axis=-1, keepdims=True) + EPS)
    return (y * g.astype(jnp.float32)).astype(x.dtype)


def t5_bucket(dist):
    max_exact = N_BUCKETS // 2
    d = jnp.maximum(dist, 0)
    df = jnp.maximum(d, 1).astype(jnp.float32)
    large = max_exact + (jnp.log(df / max_exact) / math.log(MAX_DISTANCE / max_exact)
                         * (N_BUCKETS - max_exact)).astype(jnp.int32)
    large = jnp.minimum(large, N_BUCKETS - 1)
    return jnp.where(d < max_exact, d, large)


def swa_sink_attention(q, k, v, sinks, rel_bias):
    B, S, Hq, d = q.shape
    Hkv = k.shape[2]
    G = Hq // Hkv
    nb = S // BLOCK
    qb = q.reshape(B, nb, BLOCK, Hkv, G, d)
    kb = k.reshape(B, nb, BLOCK, Hkv, d)
    vb = v.reshape(B, nb, BLOCK, Hkv, d)
    kband = jnp.concatenate([jnp.concatenate([jnp.zeros_like(kb[:, :1]), kb[:, :-1]], axis=1), kb], axis=2)
    vband = jnp.concatenate([jnp.concatenate([jnp.zeros_like(vb[:, :1]), vb[:, :-1]], axis=1), vb], axis=2)
    scores = jnp.einsum('bnqhgd,bnkhd->bnhgqk', qb, kband).astype(jnp.float32) * (d ** -0.5)
    dist = (jnp.arange(BLOCK)[:, None] + BLOCK) - jnp.arange(2 * BLOCK)[None, :]
    in_win = (dist >= 0) & (dist < SWA_WINDOW)
    bias = rel_bias.astype(jnp.float32)[t5_bucket(dist)]
    bias = bias.transpose(2, 0, 1).reshape(Hkv, G, BLOCK, 2 * BLOCK)
    k_abs = (jnp.arange(nb)[:, None] - 1) * BLOCK + jnp.arange(2 * BLOCK)[None, :]
    mask = in_win[None] & (k_abs >= 0)[:, None, :]
    scores = jnp.where(mask[None, :, None, None], scores + bias[None, None], -jnp.inf)
    sink = sinks.astype(jnp.float32).reshape(Hkv, G)[:, :, None, None]
    m = jnp.maximum(jnp.max(scores, axis=-1, keepdims=True), sink)
    p = jnp.exp(scores - m)
    w = p / (jnp.sum(p, axis=-1, keepdims=True) + jnp.exp(sink - m))
    out = jnp.einsum('bnhgqk,bnkhd->bnqhgd', w.astype(v.dtype), vband)
    return out.reshape(B, S, Hq * d)


def stick_breaking_attention(q, k, v):
    B, S, H, d = q.shape
    nb = S // BLOCK
    outs = []
    for i in range(nb):
        L = (i + 1) * BLOCK
        z = jnp.einsum('bqhd,bkhd->bhqk', q[:, i * BLOCK:L], k[:, :L]).astype(jnp.float32) * (d ** -0.5)
        t = i * BLOCK + jnp.arange(BLOCK)[:, None]
        causal = jnp.arange(L)[None, :] < t
        log_1m = jnp.where(causal, jax.nn.log_sigmoid(-z), 0.0)
        between = lax.cumsum(log_1m, axis=3, reverse=True) - log_1m
        a = jnp.where(causal, jnp.exp(jax.nn.log_sigmoid(z) + between), 0.0)
        outs.append(jnp.einsum('bhqk,bkhd->bqhd', a.astype(v.dtype), v[:, :L]))
    return jnp.concatenate(outs, axis=1).reshape(B, S, H * d)


def memory_cross_attention(q, mk, mv):
    B, S, H, d = q.shape
    z = jnp.einsum('bshd,bmhd->bhsm', q, mk).astype(jnp.float32) * (d ** -0.5)
    w = jax.nn.softmax(z, axis=-1)
    return jnp.einsum('bhsm,bmhd->bshd', w.astype(mv.dtype), mv).reshape(B, S, H * d)


def setup_inputs(seed: int = 0) -> dict:
    key = jax.random.key(seed)
    ks = jax.random.split(key, 20)
    f = jnp.float32

    def w(k, shape, fan_in):
        return jax.random.normal(k, shape, f) * fan_in ** -0.5

    def gain(k, n):
        return 1.0 + 0.01 * jax.random.normal(k, (DEPTH, n), f)

    return {
        "x": jax.random.normal(ks[0], (BATCH, SEQ, D_MODEL), f),
        "mem": jax.random.normal(ks[1], (BATCH, MEM_LEN, D_MODEL), f),
        "ln_mix_pre": gain(ks[2], D_MODEL),
        "ln_mix_post": gain(ks[3], D_MODEL),
        "w_in": w(ks[4], (DEPTH, D_MODEL, IN_W), D_MODEL),
        "swa_sinks": 0.5 * jax.random.normal(ks[5], (DEPTH, SWA_Q_HEADS), f),
        "rel_bias": 0.5 * jax.random.normal(ks[6], (N_BUCKETS, SWA_Q_HEADS), f),
        "ln_mem": gain(ks[7], D_MODEL),
        "w_mem_kv": w(ks[8], (DEPTH, D_MODEL, 2 * MEM_W), D_MODEL),
        "w_branch_swa": w(ks[9], (DEPTH, SWA_Q_W, D_MODEL), SWA_Q_W),
        "w_branch_sb": w(ks[10], (DEPTH, SB_W, D_MODEL), SB_W),
        "w_branch_mem": w(ks[11], (DEPTH, MEM_W, D_MODEL), MEM_W),
        "w_out": w(ks[12], (DEPTH, D_MODEL, D_MODEL), D_MODEL),
        "ln_ffn_pre": gain(ks[13], D_MODEL),
        "ln_ffn_post": gain(ks[14], D_MODEL),
        "w_gate": w(ks[15], (DEPTH, D_MODEL, D_FF), D_MODEL),
        "w_up": w(ks[16], (DEPTH, D_MODEL, D_FF), D_MODEL),
        "w_down": w(ks[17], (DEPTH, D_FF, D_MODEL), D_FF),
    }


def reference(x, mem, ln_mix_pre, ln_mix_post, w_in, swa_sinks, rel_bias, ln_mem, w_mem_kv,
              w_branch_swa, w_branch_sb, w_branch_mem, w_out, ln_ffn_pre, ln_ffn_post,
              w_gate, w_up, w_down):
    B, S, D = x.shape
    M = mem.shape[1]
    split_idx = list(np.cumsum(IN_SPLITS)[:-1])
    h = x
    for l in range(DEPTH):
        u = rms_norm(h, ln_mix_pre[l])
        proj = jnp.einsum('bsd,de->bse', u, w_in[l])
        qa, ka, va, qb, kb, vb, qm, gl = jnp.split(proj, split_idx, axis=-1)
        y_swa = swa_sink_attention(qa.reshape(B, S, SWA_Q_HEADS, HEAD_DIM),
                                   ka.reshape(B, S, SWA_KV_HEADS, HEAD_DIM),
                                   va.reshape(B, S, SWA_KV_HEADS, HEAD_DIM),
                                   swa_sinks[l], rel_bias)
        y_sb = stick_breaking_attention(qb.reshape(B, S, SB_HEADS, HEAD_DIM),
                                        kb.reshape(B, S, SB_HEADS, HEAD_DIM),
                                        vb.reshape(B, S, SB_HEADS, HEAD_DIM))
        mkv = jnp.einsum('bmd,de->bme', rms_norm(mem, ln_mem[l]), w_mem_kv[l])
        mk, mv = jnp.split(mkv, 2, axis=-1)
        y_mem = memory_cross_attention(qm.reshape(B, S, MEM_HEADS, MEM_HEAD_DIM),
                                       mk.reshape(B, M, MEM_HEADS, MEM_HEAD_DIM),
                                       mv.reshape(B, M, MEM_HEADS, MEM_HEAD_DIM))
        g = jax.nn.sigmoid(gl.reshape(B, S, N_BRANCH, D))
        merged = (g[:, :, 0] * jnp.einsum('bse,ed->bsd', y_swa, w_branch_swa[l])
                  + g[:, :, 1] * jnp.einsum('bse,ed->bsd', y_sb, w_branch_sb[l])
                  + g[:, :, 2] * jnp.einsum('bse,ed->bsd', y_mem, w_branch_mem[l]))
        mix = jnp.einsum('bsd,de->bse', merged, w_out[l])
        h = h + rms_norm(mix, ln_mix_post[l])
        u = rms_norm(h, ln_ffn_pre[l])
        a = jax.nn.silu(jnp.einsum('bsd,df->bsf', u, w_gate[l])) * jnp.einsum('bsd,df->bsf', u, w_up[l])
        ffn = jnp.einsum('bsf,fd->bsd', a, w_down[l])
        h = h + rms_norm(ffn, ln_ffn_post[l])
    return h
```

```cpp
#include <hip/hip_runtime.h>
#include <hip/hip_cooperative_groups.h>
#include <cstdio>
#include <cstdint>
namespace cg = cooperative_groups;

#ifndef MK_N_LAUNCHES
#define MK_N_LAUNCHES 1
#endif

namespace pg8 {
#define PG8_LAS __attribute__((address_space(3)))
typedef unsigned short bf16_t;
typedef short bf16x8 __attribute__((ext_vector_type(8)));
typedef float f32x4 __attribute__((ext_vector_type(4)));
typedef unsigned u32x4 __attribute__((ext_vector_type(4)));
constexpr int BM = 256, BK = 64, HALF = 128, HTB = HALF * BK * 2  , STAGE_BYTES = 8 * HTB, NXCD = 8, WGM = 8;

__host__ __device__ __forceinline__ int lds_byte(int r, int c) { const int st = (r >> 4) * 2 + (c >> 5), rr = r & 15, cc = c & 31, ob = rr * 64 + cc * 2; return st * 1024 + (ob ^ (((ob >> 9) & 1) << 5)); }
__host__ __device__ __forceinline__ void stage_rc(int b, int& R, int& C) { const int st = b / 1024, sb = b % 1024, swz = sb ^ (((sb >> 9) & 1) << 5); R = (st >> 1) * 16 + swz / 64; C = (st & 1) * 32 + (swz % 64) / 2; }
__host__ __device__ __forceinline__ int perm32(int rho) { const int n = rho >> 4, i = rho & 15; return 8 * (i >> 2) + 4 * n + (i & 3); }

struct Unit { int pm, pn, z; const char* a; const char* b; };
struct Gemm { int lda, ldb, K; };

__device__ __forceinline__ void tile_of(int L, int nM, int nN, int& pm, int& pn) {
    const int nwg = nM * nN; int wgid = L;
    { const int q = nwg / NXCD, r = nwg % NXCD, xcd = wgid % NXCD, off = wgid / NXCD; wgid = (xcd < r ? xcd * (q + 1) : r * (q + 1) + (xcd - r) * q) + off; }
    const int nig = WGM * nN, gid = wgid / nig, fm = gid * WGM, gsz = (nM - fm) < WGM ? (nM - fm) : WGM;
    pm = fm + ((wgid % nig) % gsz); pn = (wgid % nig) / gsz;
}

__device__ __forceinline__ unsigned cvt_pk_bf16(float lo, float hi) { unsigned r; asm volatile("v_cvt_pk_bf16_f32 %0, %1, %2" : "=v"(r) : "v"(lo), "v"(hi)); return r; }

template <class Epi, class Sched, bool ALIGN_EPI = false, bool SP2 = false>
__device__ __forceinline__ void gemm_phase(PG8_LAS unsigned char* lds, const Gemm g, const Sched& S, const Epi& E) {
    const int tid = threadIdx.x, wid = __builtin_amdgcn_readfirstlane(tid >> 6), lane = tid & 63, wr = wid >> 2, wc = wid & 3, fr = lane & 15, fq = lane >> 4;
    const int K = g.K, nt = K / BK;
    unsigned voffA[2], voffB[2];
#pragma unroll
    for (int i = 0; i < 2; ++i) { int R, C; stage_rc(tid * 16 + i * 8192, R, C); const int Rb = Epi::PERM ? ((R & ~31) + perm32(R & 31)) : R;
        voffA[i] = (unsigned)(R * g.lda + C) * 2u; voffB[i] = (unsigned)(Rb * g.ldb + C) * 2u; }
    const size_t kstep = (size_t)(BK * 2);
    const size_t hstepA = (size_t)HALF * g.lda * 2, hstepB = (size_t)HALF * g.ldb * 2;
    const unsigned ldsw = (unsigned)wid * 1024u;
    const int aoff = lds_byte(wr * 64 + fr, fq * 8), boff = lds_byte(wc * 32 + fr, fq * 8);
#define PG8_SA(b, h) (((b) * 2 + (h)) * HTB)
#define PG8_SB(b, h) ((4 + (b) * 2 + (h)) * HTB)
#define PG8_STAGE(bufoff, gbase, voff) do { _Pragma("unroll") for (int _i = 0; _i < 2; ++_i) \
        __builtin_amdgcn_global_load_lds((const unsigned*)((const char*)(gbase) + (voff)[_i]), (PG8_LAS unsigned*)(lds + (bufoff) + ldsw + _i * 8192), 16, 0, 0); } while (0)
#define PG8_LDA(dst, b, h) do { _Pragma("unroll") for (int m = 0; m < 4; ++m) _Pragma("unroll") for (int k = 0; k < 2; ++k) dst[m][k] = *(const PG8_LAS bf16x8*)(lds + PG8_SA(b, h) + aoff + m * 2048 + k * 1024); } while (0)
#define PG8_LDB(dst, b, h) do { _Pragma("unroll") for (int n = 0; n < 2; ++n) _Pragma("unroll") for (int k = 0; k < 2; ++k) dst[n][k] = *(const PG8_LAS bf16x8*)(lds + PG8_SB(b, h) + boff + n * 2048 + k * 1024); } while (0)
#define PG8_MMA(ai, bj, At, Bt) do { __builtin_amdgcn_s_setprio(1); _Pragma("unroll") for (int m = 0; m < 4; ++m) _Pragma("unroll") for (int n = 0; n < 2; ++n) _Pragma("unroll") for (int k = 0; k < 2; ++k) \
        acc[ai][bj][m][n] = __builtin_amdgcn_mfma_f32_16x16x32_bf16(Bt[n][k], At[m][k], acc[ai][bj][m][n], 0, 0, 0); __builtin_amdgcn_s_setprio(0); } while (0)
#define PG8_WAIT_V(n) asm volatile("s_waitcnt vmcnt(" #n ")" ::: "memory")
#define PG8_WAIT_L(n) asm volatile("s_waitcnt lgkmcnt(" #n ")" ::: "memory")
#define PG8_BAR __builtin_amdgcn_s_barrier()
#define PG8_SCHED __builtin_amdgcn_sched_barrier(0)
    Unit cur, nxt; int ui = 0;
    if (!S.next(0, cur)) return;
    f32x4 acc[2][2][4][2];
#pragma unroll
    for (int a = 0; a < 2; ++a)
#pragma unroll
        for (int b = 0; b < 2; ++b)
#pragma unroll
            for (int m = 0; m < 4; ++m)
#pragma unroll
                for (int n = 0; n < 2; ++n) acc[a][b][m][n] = (f32x4){0.f, 0.f, 0.f, 0.f};
    bf16x8 At[4][2], B0[2][2], B1[2][2];
    const char* cA = cur.a; const char* cB = cur.b;
    if constexpr (SP2) {
        PG8_STAGE(PG8_SB(0, 0), cB, voffB); PG8_STAGE(PG8_SB(0, 1), cB + hstepB, voffB); PG8_STAGE(PG8_SA(0, 0), cA, voffA); PG8_STAGE(PG8_SA(0, 1), cA + hstepA, voffA);
        if (wr == 1) PG8_BAR;
        PG8_WAIT_V(2); PG8_BAR;
        PG8_STAGE(PG8_SB(1, 0), cB + kstep, voffB); PG8_STAGE(PG8_SA(1, 0), cA + kstep, voffA); PG8_STAGE(PG8_SB(1, 1), cB + hstepB + kstep, voffB);
        PG8_WAIT_V(6); PG8_BAR;
    } else {
        PG8_STAGE(PG8_SB(0, 0), cB, voffB); PG8_STAGE(PG8_SA(0, 0), cA, voffA); PG8_STAGE(PG8_SB(0, 1), cB + hstepB, voffB); PG8_STAGE(PG8_SA(0, 1), cA + hstepA, voffA);
        if (wr == 1) PG8_BAR;
        PG8_WAIT_V(4); PG8_BAR;
        PG8_STAGE(PG8_SB(1, 0), cB + kstep, voffB); PG8_STAGE(PG8_SA(1, 0), cA + kstep, voffA); PG8_STAGE(PG8_SB(1, 1), cB + hstepB + kstep, voffB);
        PG8_WAIT_V(6); PG8_BAR;
    }
    for (;;) {
        const bool has_next = S.next(ui + 1, nxt);
        const char* nA = has_next ? nxt.a : cA; const char* nB = has_next ? nxt.b : cB;
        for (int t = 0; t < nt; t += 2) {
            const bool last = (t == nt - 2);
            const char* a1 = cA + (size_t)(t + 1) * kstep;
            const char* a2 = last ? nA : cA + (size_t)(t + 2) * kstep; const char* b2 = last ? nB : cB + (size_t)(t + 2) * kstep;
            const char* a3 = a2 + kstep; const char* b3 = b2 + kstep;
            if constexpr (SP2) {
            PG8_LDB(B0, 0, 0); PG8_LDB(B1, 0, 1); PG8_SCHED; PG8_LDA(At, 0, 0); PG8_STAGE(PG8_SA(1, 1), a1 + hstepA, voffA);
            PG8_WAIT_V(8); PG8_WAIT_L(0); PG8_BAR; PG8_MMA(0, 0, At, B0); PG8_MMA(0, 1, At, B1); PG8_BAR; PG8_SCHED;
            PG8_LDA(At, 0, 1); PG8_STAGE(PG8_SB(0, 0), b2, voffB); PG8_STAGE(PG8_SB(0, 1), b2 + hstepB, voffB); PG8_STAGE(PG8_SA(0, 0), a2, voffA);
            PG8_WAIT_V(8); PG8_WAIT_L(0); PG8_BAR; PG8_MMA(1, 0, At, B0); PG8_MMA(1, 1, At, B1); PG8_BAR; PG8_SCHED;
            PG8_LDB(B0, 1, 0); PG8_LDB(B1, 1, 1); PG8_SCHED; PG8_LDA(At, 1, 0); PG8_STAGE(PG8_SA(0, 1), a2 + hstepA, voffA);
            PG8_WAIT_V(8); PG8_WAIT_L(0); PG8_BAR; PG8_MMA(0, 0, At, B0); PG8_MMA(0, 1, At, B1); PG8_BAR; PG8_SCHED;
            PG8_LDA(At, 1, 1); PG8_STAGE(PG8_SB(1, 0), b3, voffB); PG8_STAGE(PG8_SB(1, 1), b3 + hstepB, voffB); PG8_STAGE(PG8_SA(1, 0), a3, voffA);
            PG8_WAIT_V(8); PG8_WAIT_L(0); PG8_BAR; PG8_MMA(1, 0, At, B0); PG8_MMA(1, 1, At, B1); PG8_BAR; PG8_SCHED;
            } else {
            PG8_LDB(B0, 0, 0); PG8_SCHED; PG8_LDA(At, 0, 0); PG8_STAGE(PG8_SA(1, 1), a1 + hstepA, voffA);
            PG8_WAIT_L(8); PG8_BAR; PG8_WAIT_L(0); PG8_MMA(0, 0, At, B0); PG8_BAR; PG8_SCHED;
            PG8_LDB(B1, 0, 1); PG8_STAGE(PG8_SB(0, 0), b2, voffB);
            PG8_BAR; PG8_WAIT_L(0); PG8_MMA(0, 1, At, B1); PG8_BAR;
            PG8_LDA(At, 0, 1); PG8_STAGE(PG8_SA(0, 0), a2, voffA);
            PG8_BAR; PG8_WAIT_L(0); PG8_MMA(1, 0, At, B0); PG8_BAR; PG8_SCHED;
            PG8_STAGE(PG8_SB(0, 1), b2 + hstepB, voffB);
            PG8_WAIT_V(6); PG8_BAR; PG8_MMA(1, 1, At, B1); PG8_BAR;
            PG8_LDB(B0, 1, 0); PG8_SCHED; PG8_LDA(At, 1, 0); PG8_STAGE(PG8_SA(0, 1), a2 + hstepA, voffA);
            PG8_WAIT_L(8); PG8_BAR; PG8_WAIT_L(0); PG8_MMA(0, 0, At, B0); PG8_BAR; PG8_SCHED;
            PG8_LDB(B1, 1, 1); PG8_STAGE(PG8_SB(1, 0), b3, voffB);
            PG8_BAR; PG8_WAIT_L(0); PG8_MMA(0, 1, At, B1); PG8_BAR;
            PG8_LDA(At, 1, 1); PG8_STAGE(PG8_SA(1, 0), a3, voffA);
            PG8_BAR; PG8_WAIT_L(0); PG8_MMA(1, 0, At, B0); PG8_BAR; PG8_SCHED;
            PG8_STAGE(PG8_SB(1, 1), b3 + hstepB, voffB);
            PG8_WAIT_V(6); PG8_BAR; PG8_MMA(1, 1, At, B1); PG8_BAR;
            }
        }
        if constexpr (ALIGN_EPI) { if (wr == 0) PG8_BAR; }
        E(acc, cur, wr, wc, fr, fq);
        if (!has_next) break;
#pragma unroll
        for (int a = 0; a < 2; ++a)
#pragma unroll
            for (int b = 0; b < 2; ++b)
#pragma unroll
                for (int m = 0; m < 4; ++m)
#pragma unroll
                    for (int n = 0; n < 2; ++n) acc[a][b][m][n] = (f32x4){0.f, 0.f, 0.f, 0.f};
        cur = nxt; cA = nA; cB = nB; ++ui;
        if constexpr (ALIGN_EPI) { if (wr == 1) PG8_BAR; }
    }
    PG8_WAIT_V(0);
    if constexpr (!ALIGN_EPI) { if (wr == 0) PG8_BAR; }
    PG8_BAR;
#undef PG8_SA
#undef PG8_SB
#undef PG8_STAGE
#undef PG8_LDA
#undef PG8_LDB
#undef PG8_MMA
#undef PG8_WAIT_V
#undef PG8_WAIT_L
#undef PG8_BAR
#undef PG8_SCHED
}
}

constexpr int NWAVES = 8;
constexpr int BATCH = 16, SEQ = 2048, DM = 1024, T = BATCH * SEQ, MEML = 256, TM = BATCH * MEML;
constexpr int INW = 5888, DFF = 2816, NGU = 2 * DFF;
constexpr int C_QA = 0, C_KA = 512, C_VA = 640, C_QB = 768, C_KB = 1280, C_VB = 1792, C_QM = 2304, C_G = 2816;
constexpr float EPS = 1e-6f;
constexpr int N_PHASES = 9;

constexpr size_t MiB = 1u << 20;
constexpr size_t WS_CTL = 0, CTL_ZERO_BYTES = 64 * 1024;
constexpr size_t WS_WIN = 1 * MiB, WS_WMKV = 13 * MiB, WS_WBR = 15 * MiB, WS_WOUT = 18 * MiB, WS_WGU = 20 * MiB, WS_WDN = 31 * MiB, WS_BIAS = 37 * MiB;
constexpr size_t WS_MN = 40 * MiB, WS_MKV = 48 * MiB, WS_XN = 56 * MiB  , WS_PROJ = 120 * MiB;
constexpr size_t WS_MIX = 120 * MiB  , WS_XN2 = 248 * MiB, WS_A = 312 * MiB, WS_END = 488 * MiB;
static_assert(WS_PROJ + (size_t)T * INW * 2 <= WS_END && WS_A + (size_t)T * DFF * 2 <= WS_END && WS_XN2 + (size_t)T * DM * 2 <= WS_A && WS_MIX + (size_t)T * DM * 4 <= WS_XN2, "d_ws map");
static_assert(WS_WIN + (size_t)INW * DM * 2 <= WS_WMKV && WS_WGU + (size_t)NGU * DM * 2 <= WS_WDN && WS_WDN + (size_t)DM * DFF * 2 <= WS_BIAS, "d_ws weight map");

constexpr int LDS_BYTES = 147456;

__device__ const unsigned char T5B[128] = {0, 1, 2, 3, 4, 5, 6, 7, 8, 9, 10, 11, 12, 13, 14, 15, 16, 16, 16, 17, 17, 18, 18, 18, 19, 19, 19, 20, 20, 20, 20, 21, 21, 21, 21, 22, 22, 22, 22, 22, 23, 23, 23, 23, 23, 23, 24, 24, 24, 24, 24, 24, 25, 25, 25, 25, 25, 25, 25, 26, 26, 26, 26, 26, 26, 26, 26, 27, 27, 27, 27, 27, 27, 27, 27, 27, 27, 28, 28, 28, 28, 28, 28, 28, 28, 28, 28, 29, 29, 29, 29, 29, 29, 29, 29, 29, 29, 29, 29, 30, 30, 30, 30, 30, 30, 30, 30, 30, 30, 30, 30, 30, 30, 31, 31, 31, 31, 31, 31, 31, 31, 31, 31, 31, 31, 31, 31, 31};

#define LAS __attribute__((address_space(3)))
typedef unsigned short bf16;
typedef unsigned v4u __attribute__((ext_vector_type(4)));
typedef unsigned v2u __attribute__((ext_vector_type(2)));
typedef float f32x4 __attribute__((ext_vector_type(4)));
#define LDS_WAIT() asm volatile("s_waitcnt lgkmcnt(0)" ::: "memory")
__device__ __forceinline__ unsigned f2bf(float f) { unsigned u = __builtin_bit_cast(unsigned, f); return (u + 0x7fffu + ((u >> 16) & 1u)) >> 16; }
__device__ __forceinline__ unsigned pk2(float lo, float hi) { return f2bf(lo) | (f2bf(hi) << 16); }
__device__ __forceinline__ float bflo(unsigned u) { return __builtin_bit_cast(float, u << 16); }
__device__ __forceinline__ float bfhi(unsigned u) { return __builtin_bit_cast(float, u & 0xffff0000u); }
__device__ __forceinline__ float bf1(bf16 h) { return __builtin_bit_cast(float, (unsigned)h << 16); }
__device__ __forceinline__ float wave_sum(float v) {
#pragma unroll
    for (int o = 1; o < 64; o <<= 1) v += __shfl_xor(v, o);
    return v;
}
__device__ __forceinline__ float wave_max(float v) {
#pragma unroll
    for (int o = 1; o < 64; o <<= 1) v = fmaxf(v, __shfl_xor(v, o));
    return v;
}
__device__ __forceinline__ float dot8(v4u a, v4u b) {
    float s = bflo(a.x) * bflo(b.x); s += bfhi(a.x) * bfhi(b.x); s += bflo(a.y) * bflo(b.y); s += bfhi(a.y) * bfhi(b.y);
    s += bflo(a.z) * bflo(b.z); s += bfhi(a.z) * bfhi(b.z); s += bflo(a.w) * bflo(b.w); s += bfhi(a.w) * bfhi(b.w); return s;
}
__device__ __forceinline__ float sigmoidf_(float x) { return 1.0f / (1.0f + __expf(-x)); }

struct Frame {
    LAS unsigned char* lds;
    int tid, lane, wave, G, gw, ngw;
    const float *x, *mem, *ln_mix_pre, *ln_mix_post, *w_in, *sinks, *rel_bias, *ln_mem, *w_mem_kv, *w_br0, *w_br1, *w_br2, *w_out, *ln_ffn_pre, *ln_ffn_post, *w_gate, *w_up, *w_down;
    float* out;
    bf16 *WinT, *WmkvT, *WbrT, *WoutT, *WguT, *WdnT, *MN, *MKV, *XN, *MERGED, *PROJ, *XN2, *AH;
    float *BIAS, *MIX;
};

__device__ __forceinline__ void p0_transpose_item(const float* W, int K, int N, bf16* WT, int drow0, int k0, int n0, LAS float* scr, int lane) {
#pragma unroll 8
    for (int i = 0; i < 32; ++i) { const int kk = 2 * i + (lane >> 5); scr[kk * 33 + (lane & 31)] = W[(size_t)(k0 + kk) * N + n0 + (lane & 31)]; }
    LDS_WAIT(); asm volatile("" ::: "memory");
    const int c = lane & 7;
#pragma unroll
    for (int j = 0; j < 4; ++j) { const int n = (lane >> 3) + 8 * j; const LAS float* s = scr + (8 * c) * 33 + n;
        v4u o; o.x = pk2(s[0 * 33], s[1 * 33]); o.y = pk2(s[2 * 33], s[3 * 33]); o.z = pk2(s[4 * 33], s[5 * 33]); o.w = pk2(s[6 * 33], s[7 * 33]);
        *(v4u*)(WT + (size_t)(drow0 + n) * K + k0 + 8 * c) = o; }
    LDS_WAIT(); asm volatile("" ::: "memory");
}
__device__ __forceinline__ void rms_row_to_bf16(const float* xrow, const float* g, bf16* orow, int lane) {
    const f32x4* xr = (const f32x4*)xrow + lane; const f32x4* gr = (const f32x4*)g + lane;
    f32x4 v[4]; float s = 0.f;
#pragma unroll
    for (int j = 0; j < 4; ++j) { v[j] = xr[64 * j]; s += (v[j].x * v[j].x + v[j].y * v[j].y) + (v[j].z * v[j].z + v[j].w * v[j].w); }
    const float rstd = 1.0f / sqrtf(wave_sum(s) * (1.f / DM) + EPS);
    v2u* o8 = (v2u*)orow + lane;
#pragma unroll
    for (int j = 0; j < 4; ++j) { const f32x4 gg = gr[64 * j]; v2u w; w.x = pk2(v[j].x * rstd * gg.x, v[j].y * rstd * gg.y); w.y = pk2(v[j].z * rstd * gg.z, v[j].w * rstd * gg.w); o8[64 * j] = w; }
}

__device__ __forceinline__ void phase_prologue(Frame& F) {
    LAS float* scr = (LAS float*)(F.lds + F.wave * 16384);
    constexpr int I_IN = (DM / 64) * (INW / 32), I_MKV = (DM / 64) * (DM / 32), I_BR = (512 / 64) * (DM / 32), I_OUT = I_MKV, I_G = (DM / 64) * (DFF / 32), I_D = (DFF / 64) * (DM / 32);
    constexpr int NITEMS = I_IN + I_MKV + 3 * I_BR + I_OUT + 2 * I_G + I_D;
    for (int it = F.gw; it < NITEMS; it += F.ngw) {
        int r = it;
        if (r < I_IN) { const int nb = r % (INW / 32), kb = r / (INW / 32); p0_transpose_item(F.w_in, DM, INW, F.WinT, 32 * nb, 64 * kb, 32 * nb, scr, F.lane); continue; } r -= I_IN;
        if (r < I_MKV) { const int nb = r % (DM / 32), kb = r / (DM / 32); p0_transpose_item(F.w_mem_kv, DM, DM, F.WmkvT, 32 * nb, 64 * kb, 32 * nb, scr, F.lane); continue; } r -= I_MKV;
        if (r < I_BR) { const int nb = r % (DM / 32), kb = r / (DM / 32); p0_transpose_item(F.w_br0, 512, DM, F.WbrT, 32 * nb, 64 * kb, 32 * nb, scr, F.lane); continue; } r -= I_BR;
        if (r < I_BR) { const int nb = r % (DM / 32), kb = r / (DM / 32); p0_transpose_item(F.w_br1, 512, DM, F.WbrT + (size_t)DM * 512, 32 * nb, 64 * kb, 32 * nb, scr, F.lane); continue; } r -= I_BR;
        if (r < I_BR) { const int nb = r % (DM / 32), kb = r / (DM / 32); p0_transpose_item(F.w_br2, 512, DM, F.WbrT + (size_t)2 * DM * 512, 32 * nb, 64 * kb, 32 * nb, scr, F.lane); continue; } r -= I_BR;
        if (r < I_OUT) { const int nb = r % (DM / 32), kb = r / (DM / 32); p0_transpose_item(F.w_out, DM, DM, F.WoutT, 32 * nb, 64 * kb, 32 * nb, scr, F.lane); continue; } r -= I_OUT;
        if (r < I_G) { const int nb = r % (DFF / 32), kb = r / (DFF / 32), n0 = 32 * nb;
            p0_transpose_item(F.w_gate, DM, DFF, F.WguT, (n0 / 128) * 256 + (n0 % 128), 64 * kb, n0, scr, F.lane); continue; } r -= I_G;
        if (r < I_G) { const int nb = r % (DFF / 32), kb = r / (DFF / 32), n0 = 32 * nb;
            p0_transpose_item(F.w_up, DM, DFF, F.WguT, (n0 / 128) * 256 + 128 + (n0 % 128), 64 * kb, n0, scr, F.lane); continue; } r -= I_G;
        { const int nb = r % (DM / 32), kb = r / (DM / 32); p0_transpose_item(F.w_down, DFF, DM, F.WdnT, 32 * nb, 64 * kb, 32 * nb, scr, F.lane); }
    }
    for (int m = F.gw; m < T; m += F.ngw) rms_row_to_bf16(F.x + (size_t)m * DM, F.ln_mix_pre, F.XN + (size_t)m * DM, F.lane);
    for (int m = F.gw; m < TM; m += F.ngw) rms_row_to_bf16(F.mem + (size_t)m * DM, F.ln_mem, F.MN + (size_t)m * DM, F.lane);
    for (int i = blockIdx.x * (NWAVES * 64) + F.tid; i < 128 * 8; i += F.G * NWAVES * 64) F.BIAS[i] = F.rel_bias[(int)T5B[i >> 3] * 8 + (i & 7)];
}

struct SchedProj {
    int G, c; const char *XN, *MN, *WinT, *WmkvT;
    __device__ __forceinline__ bool next(int i, pg8::Unit& u) const {
        const int L = i * G + c; constexpr int N1 = (T / 256) * (INW / 256), N2 = (TM / 256) * (DM / 256);
        if (L < N1) { pg8::tile_of(L, T / 256, INW / 256, u.pm, u.pn); u.z = 0; u.a = XN + (size_t)u.pm * 256 * DM * 2; u.b = WinT + (size_t)u.pn * 256 * DM * 2; return true; }
        if (L < N1 + N2) { const int l = L - N1; u.pm = l >> 2; u.pn = l & 3; u.z = 1; u.a = MN + (size_t)u.pm * 256 * DM * 2; u.b = WmkvT + (size_t)u.pn * 256 * DM * 2; return true; }
        return false;
    }
};
struct EpiProj {
    static constexpr bool PERM = true;
    bf16 *PROJ, *MKV;
    __device__ __forceinline__ void operator()(const pg8::f32x4 (&acc)[2][2][4][2], const pg8::Unit& u, int wr, int wc, int fr, int fq) const {
        bf16* base = u.z ? MKV : PROJ; const int ldc = u.z ? DM : INW; const bool sig = (u.z == 0) && (u.pn * 256 >= C_G);
        const int row0 = u.pm * 256 + wr * 64 + fr, col0 = u.pn * 256 + wc * 32 + 8 * fq;
#pragma unroll
        for (int ai = 0; ai < 2; ++ai)
#pragma unroll
            for (int m = 0; m < 4; ++m) { bf16* rowp = base + (size_t)(row0 + ai * 128 + m * 16) * ldc + col0;
#pragma unroll
                for (int bj = 0; bj < 2; ++bj) { pg8::f32x4 v0 = acc[ai][bj][m][0], v1 = acc[ai][bj][m][1];
                    if (sig) {
#pragma unroll
                        for (int e = 0; e < 4; ++e) { v0[e] = sigmoidf_(v0[e]); v1[e] = sigmoidf_(v1[e]); } }
                    pg8::u32x4 w; w.x = pg8::cvt_pk_bf16(v0[0], v0[1]); w.y = pg8::cvt_pk_bf16(v0[2], v0[3]); w.z = pg8::cvt_pk_bf16(v1[0], v1[1]); w.w = pg8::cvt_pk_bf16(v1[2], v1[3]);
                    *(pg8::u32x4*)(rowp + bj * 128) = w; } }
    }
};
struct SchedMerge {
    int G, c; const char *PROJ, *WbrT;
    __device__ __forceinline__ bool next(int i, pg8::Unit& u) const {
        const int ti = i / 3, z = i - 3 * ti, L = ti * G + c;
        if (L >= (T / 256) * (DM / 256)) return false;
        pg8::tile_of(L, T / 256, DM / 256, u.pm, u.pn); u.z = z;
        const int ycol = z == 0 ? C_QA : (z == 1 ? C_QB : C_QM);
        u.a = PROJ + ((size_t)u.pm * 256 * INW + ycol) * 2; u.b = WbrT + ((size_t)z * DM * 512 + (size_t)u.pn * 256 * 512) * 2; return true;
    }
};
struct EpiMerge {
    static constexpr bool PERM = true;
    const bf16* PROJ; bf16* MERGED;
    __device__ __forceinline__ void operator()(const pg8::f32x4 (&acc)[2][2][4][2], const pg8::Unit& u, int wr, int wc, int fr, int fq) const {
        const int row0 = u.pm * 256 + wr * 64 + fr, col0 = u.pn * 256 + wc * 32 + 8 * fq;
#pragma unroll
        for (int ai = 0; ai < 2; ++ai)
#pragma unroll
            for (int m = 0; m < 4; ++m) { const size_t row = (size_t)(row0 + ai * 128 + m * 16);
#pragma unroll
                for (int bj = 0; bj < 2; ++bj) { const int col = col0 + bj * 128;
                    const pg8::u32x4 gq = *(const pg8::u32x4*)(PROJ + row * INW + C_G + u.z * DM + col);
                    pg8::f32x4 v0 = acc[ai][bj][m][0], v1 = acc[ai][bj][m][1];
                    v0[0] *= bflo(gq.x); v0[1] *= bfhi(gq.x); v0[2] *= bflo(gq.y); v0[3] *= bfhi(gq.y); v1[0] *= bflo(gq.z); v1[1] *= bfhi(gq.z); v1[2] *= bflo(gq.w); v1[3] *= bfhi(gq.w);
                    bf16* mp = MERGED + row * DM + col;
                    if (u.z != 0) { const pg8::u32x4 mq = *(const pg8::u32x4*)mp;
                        v0[0] += bflo(mq.x); v0[1] += bfhi(mq.x); v0[2] += bflo(mq.y); v0[3] += bfhi(mq.y); v1[0] += bflo(mq.z); v1[1] += bfhi(mq.z); v1[2] += bflo(mq.w); v1[3] += bfhi(mq.w); }
                    pg8::u32x4 w; w.x = pg8::cvt_pk_bf16(v0[0], v0[1]); w.y = pg8::cvt_pk_bf16(v0[2], v0[3]); w.z = pg8::cvt_pk_bf16(v1[0], v1[1]); w.w = pg8::cvt_pk_bf16(v1[2], v1[3]);
                    *(pg8::u32x4*)mp = w; } }
    }
};
struct SchedPlain {
    int G, c, nM, nN; const char *A, *Bt; size_t astep, bstep;
    __device__ __forceinline__ bool next(int i, pg8::Unit& u) const {
        const int L = i * G + c; if (L >= nM * nN) return false;
        pg8::tile_of(L, nM, nN, u.pm, u.pn); u.z = 0; u.a = A + (size_t)u.pm * astep; u.b = Bt + (size_t)u.pn * bstep; return true;
    }
};
struct EpiF32 {
    static constexpr bool PERM = false;
    float* C; int ldc;
    __device__ __forceinline__ void operator()(const pg8::f32x4 (&acc)[2][2][4][2], const pg8::Unit& u, int wr, int wc, int fr, int fq) const {
        const int row0 = u.pm * 256 + wr * 64 + fr, col0 = u.pn * 256 + wc * 32 + 4 * fq;
#pragma unroll
        for (int ai = 0; ai < 2; ++ai)
#pragma unroll
            for (int m = 0; m < 4; ++m) { float* rowp = C + (size_t)(row0 + ai * 128 + m * 16) * ldc + col0;
#pragma unroll
                for (int bj = 0; bj < 2; ++bj)
#pragma unroll
                    for (int n = 0; n < 2; ++n) *(pg8::f32x4*)(rowp + bj * 128 + n * 16) = acc[ai][bj][m][n]; }
    }
};
struct EpiSwiGLU {
    static constexpr bool PERM = true;
    bf16* AH;
    __device__ __forceinline__ void operator()(const pg8::f32x4 (&acc)[2][2][4][2], const pg8::Unit& u, int wr, int wc, int fr, int fq) const {
        const int row0 = u.pm * 256 + wr * 64 + fr, col0 = u.pn * 128 + wc * 32 + 8 * fq;
#pragma unroll
        for (int ai = 0; ai < 2; ++ai)
#pragma unroll
            for (int m = 0; m < 4; ++m) { bf16* rowp = AH + (size_t)(row0 + ai * 128 + m * 16) * DFF + col0;
                float o[8];
#pragma unroll
                for (int n = 0; n < 2; ++n)
#pragma unroll
                    for (int e = 0; e < 4; ++e) { const float gv = acc[ai][0][m][n][e], uv = acc[ai][1][m][n][e]; o[4 * n + e] = gv * sigmoidf_(gv) * uv; }
                pg8::u32x4 w; w.x = pg8::cvt_pk_bf16(o[0], o[1]); w.y = pg8::cvt_pk_bf16(o[2], o[3]); w.z = pg8::cvt_pk_bf16(o[4], o[5]); w.w = pg8::cvt_pk_bf16(o[6], o[7]);
                *(pg8::u32x4*)rowp = w; }
    }
};

__device__ __forceinline__ void attn_swa_row(Frame& F, int row, int hq) {
    const int lane = F.lane, t = row % SEQ, kvh = hq >> 2;
    const bf16* qp = F.PROJ + (size_t)row * INW + C_QA + hq * 64;
    v4u q[8];
#pragma unroll
    for (int i = 0; i < 8; ++i) q[i] = *(const v4u*)(qp + 8 * i);
    float sc[2]; bool val[2];
#pragma unroll
    for (int j = 0; j < 2; ++j) { const int dist = lane + 64 * j, s = t - dist; val[j] = s >= 0; sc[j] = -INFINITY;
        if (val[j]) { const bf16* kp = F.PROJ + (size_t)(row - dist) * INW + C_KA + kvh * 64; float a = 0.f;
#pragma unroll
            for (int i = 0; i < 8; ++i) a += dot8(q[i], *(const v4u*)(kp + 8 * i));
            sc[j] = a * 0.125f + F.BIAS[dist * 8 + hq]; } }
    const float sink = F.sinks[hq];
    const float mx = fmaxf(wave_max(fmaxf(sc[0], sc[1])), sink);
    float p0 = val[0] ? __expf(sc[0] - mx) : 0.f, p1 = val[1] ? __expf(sc[1] - mx) : 0.f;
    const float den = wave_sum(p0 + p1) + __expf(sink - mx);
    p0 /= den; p1 /= den;
    float y = 0.f; const int nk = t < 127 ? t + 1 : 128;
    const bf16* vp = F.PROJ + (size_t)row * INW + C_VA + kvh * 64 + lane;
    for (int d = 0; d < nk; ++d) { const float w = __shfl(d < 64 ? p0 : p1, d & 63); y += w * bf1(vp[-(ptrdiff_t)d * INW]); }
    ((bf16*)qp)[lane] = (bf16)f2bf(y);
}
__device__ __forceinline__ void attn_sb_row(Frame& F, int row, int h) {
    const int lane = F.lane, t = row % SEQ;
    const bf16* qp = F.PROJ + (size_t)row * INW + C_QB + h * 64;
    v4u q[8];
#pragma unroll
    for (int i = 0; i < 8; ++i) q[i] = *(const v4u*)(qp + 8 * i);
    float carry = 1.f, y = 0.f;
    for (int base = t - 1; base >= 0 && carry != 0.f; base -= 64) {
        const int s = base - lane; const bool valid = s >= 0;
        float beta = 0.f, c = 1.f;
        if (valid) { const bf16* kp = F.PROJ + (size_t)(row - t + s) * INW + C_KB + h * 64; float a = 0.f;
#pragma unroll
            for (int i = 0; i < 8; ++i) a += dot8(q[i], *(const v4u*)(kp + 8 * i));
            const float z = fmaxf(a * 0.125f, -80.f), e = __expf(-z); beta = 1.0f / (1.0f + e); c = e * beta; }
        float incl = c;
#pragma unroll
        for (int o = 1; o < 64; o <<= 1) { const float tq = __shfl_up(incl, o); if (lane >= o) incl *= tq; }
        float excl = __shfl_up(incl, 1); if (lane == 0) excl = 1.f;
        const float a = beta * excl * carry;
        carry *= __shfl(incl, 63);
        const int nv = base + 1 < 64 ? base + 1 : 64;
        const bf16* vp = F.PROJ + (size_t)(row - t + base) * INW + C_VB + h * 64 + lane;
        for (int j = 0; j < nv; ++j) { const float w = __shfl(a, j); y += w * bf1(vp[-(ptrdiff_t)j * INW]); }
    }
    ((bf16*)qp)[lane] = (bf16)f2bf(y);
}
__device__ __forceinline__ void attn_mem_row(Frame& F, int row, int h) {
    const int lane = F.lane, b = row / SEQ;
    const bf16* qp = F.PROJ + (size_t)row * INW + C_QM + h * 128;
    v4u q[16];
#pragma unroll
    for (int i = 0; i < 16; ++i) q[i] = *(const v4u*)(qp + 8 * i);
    float sc[4];
#pragma unroll
    for (int j = 0; j < 4; ++j) { const bf16* kp = F.MKV + (size_t)(b * MEML + lane + 64 * j) * DM + h * 128; float a = 0.f;
#pragma unroll
        for (int i = 0; i < 16; ++i) a += dot8(q[i], *(const v4u*)(kp + 8 * i));
        sc[j] = a * 0.08838834764831845f; }
    const float mx = wave_max(fmaxf(fmaxf(sc[0], sc[1]), fmaxf(sc[2], sc[3])));
    float p[4]; float ps = 0.f;
#pragma unroll
    for (int j = 0; j < 4; ++j) { p[j] = __expf(sc[j] - mx); ps += p[j]; }
    const float den = wave_sum(ps);
    float y0 = 0.f, y1 = 0.f;
    const bf16* vp = F.MKV + (size_t)(b * MEML) * DM + 512 + h * 128 + lane;
#pragma unroll
    for (int j = 0; j < 4; ++j)
        for (int m = 0; m < 64; ++m) { const float w = __shfl(p[j], m); const bf16* v = vp + (size_t)(64 * j + m) * DM; y0 += w * bf1(v[0]); y1 += w * bf1(v[64]); }
    ((bf16*)qp)[lane] = (bf16)f2bf(y0 / den); ((bf16*)qp)[lane + 64] = (bf16)f2bf(y1 / den);
}
__device__ __forceinline__ void phase_attention(Frame& F) {
    for (int it = F.gw; it < T * 8; it += F.ngw) attn_sb_row(F, it >> 3, it & 7);
    for (int it = F.gw; it < T * 8; it += F.ngw) attn_swa_row(F, it >> 3, it & 7);
    for (int it = F.gw; it < T * 4; it += F.ngw) attn_mem_row(F, it >> 2, it & 3);
}

__device__ __forceinline__ void phase_norm1(Frame& F) {
    for (int m = F.gw; m < T; m += F.ngw) {
        const f32x4* mr = (const f32x4*)(F.MIX + (size_t)m * DM) + F.lane; const f32x4* xr = (const f32x4*)(F.x + (size_t)m * DM) + F.lane;
        const f32x4* g1 = (const f32x4*)F.ln_mix_post + F.lane; const f32x4* g2 = (const f32x4*)F.ln_ffn_pre + F.lane;
        f32x4 v[4]; float s = 0.f;
#pragma unroll
        for (int j = 0; j < 4; ++j) { v[j] = mr[64 * j]; s += (v[j].x * v[j].x + v[j].y * v[j].y) + (v[j].z * v[j].z + v[j].w * v[j].w); }
        const float rstd = 1.0f / sqrtf(wave_sum(s) * (1.f / DM) + EPS);
        float s2 = 0.f; f32x4* orow = (f32x4*)(F.out + (size_t)m * DM) + F.lane;
#pragma unroll
        for (int j = 0; j < 4; ++j) { v[j] = xr[64 * j] + v[j] * rstd * g1[64 * j]; orow[64 * j] = v[j]; s2 += (v[j].x * v[j].x + v[j].y * v[j].y) + (v[j].z * v[j].z + v[j].w * v[j].w); }
        const float rstd2 = 1.0f / sqrtf(wave_sum(s2) * (1.f / DM) + EPS);
        v2u* o8 = (v2u*)(F.XN2 + (size_t)m * DM) + F.lane;
#pragma unroll
        for (int j = 0; j < 4; ++j) { const f32x4 gg = g2[64 * j]; v2u w; w.x = pk2(v[j].x * rstd2 * gg.x, v[j].y * rstd2 * gg.y); w.y = pk2(v[j].z * rstd2 * gg.z, v[j].w * rstd2 * gg.w); o8[64 * j] = w; }
    }
}
__device__ __forceinline__ void phase_norm2(Frame& F) {
    for (int m = F.gw; m < T; m += F.ngw) {
        const f32x4* fr = (const f32x4*)(F.MIX + (size_t)m * DM) + F.lane; f32x4* orow = (f32x4*)(F.out + (size_t)m * DM) + F.lane;
        const f32x4* g1 = (const f32x4*)F.ln_ffn_post + F.lane;
        f32x4 v[4]; float s = 0.f;
#pragma unroll
        for (int j = 0; j < 4; ++j) { v[j] = fr[64 * j]; s += (v[j].x * v[j].x + v[j].y * v[j].y) + (v[j].z * v[j].z + v[j].w * v[j].w); }
        const float rstd = 1.0f / sqrtf(wave_sum(s) * (1.f / DM) + EPS);
#pragma unroll
        for (int j = 0; j < 4; ++j) orow[64 * j] = orow[64 * j] + v[j] * rstd * g1[64 * j];
    }
}

struct Args { const float* in[18]; float* out; unsigned char* ws; int ph_lo, ph_hi; };
__global__ void __launch_bounds__(NWAVES * 64, 2) mk_fwd(Args args) {
    extern __shared__ __attribute__((aligned(16))) unsigned char lds[];
    Frame F;
    F.lds = (LAS unsigned char*)lds;
    F.tid = threadIdx.x; F.lane = F.tid & 63; F.wave = __builtin_amdgcn_readfirstlane(F.tid >> 6);
    F.G = gridDim.x; F.gw = blockIdx.x * NWAVES + F.wave; F.ngw = F.G * NWAVES;
    unsigned char* ws = args.ws;
    F.x = args.in[0]; F.mem = args.in[1]; F.ln_mix_pre = args.in[2]; F.ln_mix_post = args.in[3]; F.w_in = args.in[4]; F.sinks = args.in[5]; F.rel_bias = args.in[6]; F.ln_mem = args.in[7];
    F.w_mem_kv = args.in[8]; F.w_br0 = args.in[9]; F.w_br1 = args.in[10]; F.w_br2 = args.in[11]; F.w_out = args.in[12]; F.ln_ffn_pre = args.in[13]; F.ln_ffn_post = args.in[14];
    F.w_gate = args.in[15]; F.w_up = args.in[16]; F.w_down = args.in[17]; F.out = args.out;
    F.WinT = (bf16*)(ws + WS_WIN); F.WmkvT = (bf16*)(ws + WS_WMKV); F.WbrT = (bf16*)(ws + WS_WBR); F.WoutT = (bf16*)(ws + WS_WOUT); F.WguT = (bf16*)(ws + WS_WGU); F.WdnT = (bf16*)(ws + WS_WDN);
    F.BIAS = (float*)(ws + WS_BIAS); F.MN = (bf16*)(ws + WS_MN); F.MKV = (bf16*)(ws + WS_MKV); F.XN = (bf16*)(ws + WS_XN); F.MERGED = (bf16*)(ws + WS_XN); F.PROJ = (bf16*)(ws + WS_PROJ);
    F.MIX = (float*)(ws + WS_MIX); F.XN2 = (bf16*)(ws + WS_XN2); F.AH = (bf16*)(ws + WS_A);
    const int lo = args.ph_lo, hi = args.ph_hi;
#define IN(k) (lo <= (k) && (k) < hi)
#define SEAM(k) do { if (IN(k) && IN((k) + 1)) { cg::this_grid().sync(); } } while (0)
    const int c = (int)blockIdx.x;

    if (IN(0)) { phase_prologue(F); }
    SEAM(0);
    if (IN(1)) {
        pg8::Gemm g{DM, DM, DM}; SchedProj S{F.G, c, (const char*)F.XN, (const char*)F.MN, (const char*)F.WinT, (const char*)F.WmkvT}; EpiProj E{F.PROJ, F.MKV};
        pg8::gemm_phase<EpiProj, SchedProj, true, true>(F.lds, g, S, E);
    }
    SEAM(1);
    if (IN(2)) { phase_attention(F); }
    SEAM(2);
    if (IN(3)) {
        pg8::Gemm g{INW, 512, 512}; SchedMerge S{F.G, c, (const char*)F.PROJ, (const char*)F.WbrT}; EpiMerge E{F.PROJ, F.MERGED};
        pg8::gemm_phase<EpiMerge, SchedMerge, true, true>(F.lds, g, S, E);
    }
    SEAM(3);
    if (IN(4)) {
        pg8::Gemm g{DM, DM, DM}; SchedPlain S{F.G, c, T / 256, DM / 256, (const char*)F.MERGED, (const char*)F.WoutT, (size_t)256 * DM * 2, (size_t)256 * DM * 2}; EpiF32 E{F.MIX, DM};
        pg8::gemm_phase<EpiF32, SchedPlain, true, true>(F.lds, g, S, E);
    }
    SEAM(4);
    if (IN(5)) { phase_norm1(F); }
    SEAM(5);
    if (IN(6)) {
        pg8::Gemm g{DM, DM, DM}; SchedPlain S{F.G, c, T / 256, NGU / 256, (const char*)F.XN2, (const char*)F.WguT, (size_t)256 * DM * 2, (size_t)256 * DM * 2}; EpiSwiGLU E{F.AH};
        pg8::gemm_phase<EpiSwiGLU, SchedPlain, true, true>(F.lds, g, S, E);
    }
    SEAM(6);
    if (IN(7)) {
        pg8::Gemm g{DFF, DFF, DFF}; SchedPlain S{F.G, c, T / 256, DM / 256, (const char*)F.AH, (const char*)F.WdnT, (size_t)256 * DFF * 2, (size_t)256 * DFF * 2}; EpiF32 E{F.MIX, DM};
        pg8::gemm_phase<EpiF32, SchedPlain, true, true>(F.lds, g, S, E);
    }
    SEAM(7);
    if (IN(8)) { phase_norm2(F); }
#undef IN
#undef SEAM
}

extern "C" void kernel_launch(void* const* d_in, const int* in_sizes, int n_in, void* d_out, int out_size, void* d_ws, size_t ws_size, hipStream_t stream) {
    static int grid = 0;
    if (grid == 0) {
        if (n_in != 18 || in_sizes[0] != T * DM || out_size != T * DM || ws_size < WS_END) { fprintf(stderr, "kernel_launch: unexpected shapes: n_in %d in0 %d out %d ws %zu (need %zu)\n", n_in, n_in > 0 ? in_sizes[0] : -1, out_size, ws_size, (size_t)WS_END); grid = -1; return; }
        int dev = 0, cus = 0, per_cu = 0;
        if (hipGetDevice(&dev) != hipSuccess || hipDeviceGetAttribute(&cus, hipDeviceAttributeMultiprocessorCount, dev) != hipSuccess) { grid = -1; return; }
        if (hipFuncSetAttribute((const void*)mk_fwd, hipFuncAttributeMaxDynamicSharedMemorySize, LDS_BYTES) != hipSuccess) { fprintf(stderr, "kernel_launch: hipFuncSetAttribute failed\n"); grid = -1; return; }
        if (hipOccupancyMaxActiveBlocksPerMultiprocessor(&per_cu, (const void*)mk_fwd, NWAVES * 64, LDS_BYTES) != hipSuccess || per_cu < 1) { fprintf(stderr, "kernel_launch: occupancy query says %d\n", per_cu); per_cu = 1; }
        (void)hipGetLastError();
        grid = cus;
    }
    if (grid < 0) return;
    Args a{};
    for (int i = 0; i < 18; ++i) a.in[i] = (const float*)d_in[i];
    a.out = (float*)d_out; a.ws = (unsigned char*)d_ws;
#if MK_N_LAUNCHES == 1
    a.ph_lo = 0; a.ph_hi = N_PHASES;
    void* kargs[] = {&a};
    hipError_t e = hipLaunchCooperativeKernel((const void*)mk_fwd, dim3(grid), dim3(NWAVES * 64), kargs, LDS_BYTES, stream);
    if (e != hipSuccess) fprintf(stderr, "kernel_launch: cooperative launch failed: %s (grid %d)\n", hipGetErrorString(e), grid);
#else
    for (int p = 0; p < N_PHASES; ++p) {
        a.ph_lo = p; a.ph_hi = p + 1;
        hipLaunchKernelGGL(mk_fwd, dim3(grid), dim3(NWAVES * 64), LDS_BYTES, stream, a);
    }
#endif
}
```

```cpp
#include <hip/hip_runtime.h>
#include <hip/hip_cooperative_groups.h>
#include <cstdio>
#include <cstdint>
namespace cg = cooperative_groups;

#ifndef MK_N_LAUNCHES
#define MK_N_LAUNCHES 1
#endif

namespace pg8 {
#define PG8_LAS __attribute__((address_space(3)))
typedef unsigned short bf16_t;
typedef short bf16x8 __attribute__((ext_vector_type(8)));
typedef float f32x4 __attribute__((ext_vector_type(4)));
typedef unsigned u32x4 __attribute__((ext_vector_type(4)));
constexpr int BM = 256, BK = 64, HALF = 128, HTB = HALF * BK * 2  , STAGE_BYTES = 8 * HTB, NXCD = 8, WGM = 8;

__host__ __device__ __forceinline__ int lds_byte(int r, int c) { const int st = (r >> 4) * 2 + (c >> 5), rr = r & 15, cc = c & 31, ob = rr * 64 + cc * 2; return st * 1024 + (ob ^ (((ob >> 9) & 1) << 5)); }
__host__ __device__ __forceinline__ void stage_rc(int b, int& R, int& C) { const int st = b / 1024, sb = b % 1024, swz = sb ^ (((sb >> 9) & 1) << 5); R = (st >> 1) * 16 + swz / 64; C = (st & 1) * 32 + (swz % 64) / 2; }
__host__ __device__ __forceinline__ int perm32(int rho) { const int n = rho >> 4, i = rho & 15; return 8 * (i >> 2) + 4 * n + (i & 3); }

struct Unit { int pm, pn, z; const char* a; const char* b; };
struct Gemm { int lda, ldb, K; };

__device__ __forceinline__ void tile_of(int L, int nM, int nN, int& pm, int& pn) {
    const int nwg = nM * nN; int wgid = L;
    { const int q = nwg / NXCD, r = nwg % NXCD, xcd = wgid % NXCD, off = wgid / NXCD; wgid = (xcd < r ? xcd * (q + 1) : r * (q + 1) + (xcd - r) * q) + off; }
    const int nig = WGM * nN, gid = wgid / nig, fm = gid * WGM, gsz = (nM - fm) < WGM ? (nM - fm) : WGM;
    pm = fm + ((wgid % nig) % gsz); pn = (wgid % nig) / gsz;
}

__device__ __forceinline__ unsigned cvt_pk_bf16(float lo, float hi) { unsigned r; asm volatile("v_cvt_pk_bf16_f32 %0, %1, %2" : "=v"(r) : "v"(lo), "v"(hi)); return r; }

template <class Epi, class Sched, bool ALIGN_EPI = false, bool SP2 = false>
__device__ __forceinline__ void gemm_phase(PG8_LAS unsigned char* lds, const Gemm g, const Sched& S, const Epi& E) {
    const int tid = threadIdx.x, wid = __builtin_amdgcn_readfirstlane(tid >> 6), lane = tid & 63, wr = wid >> 2, wc = wid & 3, fr = lane & 15, fq = lane >> 4;
    const int K = g.K, nt = K / BK;
    unsigned voffA[2], voffB[2];
#pragma unroll
    for (int i = 0; i < 2; ++i) { int R, C; stage_rc(tid * 16 + i * 8192, R, C); const int Rb = Epi::PERM ? ((R & ~31) + perm32(R & 31)) : R;
        voffA[i] = (unsigned)(R * g.lda + C) * 2u; voffB[i] = (unsigned)(Rb * g.ldb + C) * 2u; }
    const size_t kstep = (size_t)(BK * 2);
    const size_t hstepA = (size_t)HALF * g.lda * 2, hstepB = (size_t)HALF * g.ldb * 2;
    const unsigned ldsw = (unsigned)wid * 1024u;
    const int aoff = lds_byte(wr * 64 + fr, fq * 8), boff = lds_byte(wc * 32 + fr, fq * 8);
#define PG8_SA(b, h) (((b) * 2 + (h)) * HTB)
#define PG8_SB(b, h) ((4 + (b) * 2 + (h)) * HTB)
#define PG8_STAGE(bufoff, gbase, voff) do { _Pragma("unroll") for (int _i = 0; _i < 2; ++_i) \
        __builtin_amdgcn_global_load_lds((const unsigned*)((const char*)(gbase) + (voff)[_i]), (PG8_LAS unsigned*)(lds + (bufoff) + ldsw + _i * 8192), 16, 0, 0); } while (0)
#define PG8_LDA(dst, b, h) do { _Pragma("unroll") for (int m = 0; m < 4; ++m) _Pragma("unroll") for (int k = 0; k < 2; ++k) dst[m][k] = *(const PG8_LAS bf16x8*)(lds + PG8_SA(b, h) + aoff + m * 2048 + k * 1024); } while (0)
#define PG8_LDB(dst, b, h) do { _Pragma("unroll") for (int n = 0; n < 2; ++n) _Pragma("unroll") for (int k = 0; k < 2; ++k) dst[n][k] = *(const PG8_LAS bf16x8*)(lds + PG8_SB(b, h) + boff + n * 2048 + k * 1024); } while (0)
#define PG8_MMA(ai, bj, At, Bt) do { __builtin_amdgcn_s_setprio(1); _Pragma("unroll") for (int m = 0; m < 4; ++m) _Pragma("unroll") for (int n = 0; n < 2; ++n) _Pragma("unroll") for (int k = 0; k < 2; ++k) \
        acc[ai][bj][m][n] = __builtin_amdgcn_mfma_f32_16x16x32_bf16(Bt[n][k], At[m][k], acc[ai][bj][m][n], 0, 0, 0); __builtin_amdgcn_s_setprio(0); } while (0)
#define PG8_WAIT_V(n) asm volatile("s_waitcnt vmcnt(" #n ")" ::: "memory")
#define PG8_WAIT_L(n) asm volatile("s_waitcnt lgkmcnt(" #n ")" ::: "memory")
#define PG8_BAR __builtin_amdgcn_s_barrier()
#define PG8_SCHED __builtin_amdgcn_sched_barrier(0)
    Unit cur, nxt; int ui = 0;
    if (!S.next(0, cur)) return;
    f32x4 acc[2][2][4][2];
#pragma unroll
    for (int a = 0; a < 2; ++a)
#pragma unroll
        for (int b = 0; b < 2; ++b)
#pragma unroll
            for (int m = 0; m < 4; ++m)
#pragma unroll
                for (int n = 0; n < 2; ++n) acc[a][b][m][n] = (f32x4){0.f, 0.f, 0.f, 0.f};
    bf16x8 At[4][2], B0[2][2], B1[2][2];
    const char* cA = cur.a; const char* cB = cur.b;
    if constexpr (SP2) {
        PG8_STAGE(PG8_SB(0, 0), cB, voffB); PG8_STAGE(PG8_SB(0, 1), cB + hstepB, voffB); PG8_STAGE(PG8_SA(0, 0), cA, voffA); PG8_STAGE(PG8_SA(0, 1), cA + hstepA, voffA);
        if (wr == 1) PG8_BAR;
        PG8_WAIT_V(2); PG8_BAR;
        PG8_STAGE(PG8_SB(1, 0), cB + kstep, voffB); PG8_STAGE(PG8_SA(1, 0), cA + kstep, voffA); PG8_STAGE(PG8_SB(1, 1), cB + hstepB + kstep, voffB);
        PG8_WAIT_V(6); PG8_BAR;
    } else {
        PG8_STAGE(PG8_SB(0, 0), cB, voffB); PG8_STAGE(PG8_SA(0, 0), cA, voffA); PG8_STAGE(PG8_SB(0, 1), cB + hstepB, voffB); PG8_STAGE(PG8_SA(0, 1), cA + hstepA, voffA);
        if (wr == 1) PG8_BAR;
        PG8_WAIT_V(4); PG8_BAR;
        PG8_STAGE(PG8_SB(1, 0), cB + kstep, voffB); PG8_STAGE(PG8_SA(1, 0), cA + kstep, voffA); PG8_STAGE(PG8_SB(1, 1), cB + hstepB + kstep, voffB);
        PG8_WAIT_V(6); PG8_BAR;
    }
    for (;;) {
        const bool has_next = S.next(ui + 1, nxt);
        const char* nA = has_next ? nxt.a : cA; const char* nB = has_next ? nxt.b : cB;
        for (int t = 0; t < nt; t += 2) {
            const bool last = (t == nt - 2);
            const char* a1 = cA + (size_t)(t + 1) * kstep;
            const char* a2 = last ? nA : cA + (size_t)(t + 2) * kstep; const char* b2 = last ? nB : cB + (size_t)(t + 2) * kstep;
            const char* a3 = a2 + kstep; const char* b3 = b2 + kstep;
            if constexpr (SP2) {
            PG8_LDB(B0, 0, 0); PG8_LDB(B1, 0, 1); PG8_SCHED; PG8_LDA(At, 0, 0); PG8_STAGE(PG8_SA(1, 1), a1 + hstepA, voffA);
            PG8_WAIT_V(8); PG8_WAIT_L(0); PG8_BAR; PG8_MMA(0, 0, At, B0); PG8_MMA(0, 1, At, B1); PG8_BAR; PG8_SCHED;
            PG8_LDA(At, 0, 1); PG8_STAGE(PG8_SB(0, 0), b2, voffB); PG8_STAGE(PG8_SB(0, 1), b2 + hstepB, voffB); PG8_STAGE(PG8_SA(0, 0), a2, voffA);
            PG8_WAIT_V(8); PG8_WAIT_L(0); PG8_BAR; PG8_MMA(1, 0, At, B0); PG8_MMA(1, 1, At, B1); PG8_BAR; PG8_SCHED;
            PG8_LDB(B0, 1, 0); PG8_LDB(B1, 1, 1); PG8_SCHED; PG8_LDA(At, 1, 0); PG8_STAGE(PG8_SA(0, 1), a2 + hstepA, voffA);
            PG8_WAIT_V(8); PG8_WAIT_L(0); PG8_BAR; PG8_MMA(0, 0, At, B0); PG8_MMA(0, 1, At, B1); PG8_BAR; PG8_SCHED;
            PG8_LDA(At, 1, 1); PG8_STAGE(PG8_SB(1, 0), b3, voffB); PG8_STAGE(PG8_SB(1, 1), b3 + hstepB, voffB); PG8_STAGE(PG8_SA(1, 0), a3, voffA);
            PG8_WAIT_V(8); PG8_WAIT_L(0); PG8_BAR; PG8_MMA(1, 0, At, B0); PG8_MMA(1, 1, At, B1); PG8_BAR; PG8_SCHED;
            } else {
            PG8_LDB(B0, 0, 0); PG8_SCHED; PG8_LDA(At, 0, 0); PG8_STAGE(PG8_SA(1, 1), a1 + hstepA, voffA);
            PG8_WAIT_L(8); PG8_BAR; PG8_WAIT_L(0); PG8_MMA(0, 0, At, B0); PG8_BAR; PG8_SCHED;
            PG8_LDB(B1, 0, 1); PG8_STAGE(PG8_SB(0, 0), b2, voffB);
            PG8_BAR; PG8_WAIT_L(0); PG8_MMA(0, 1, At, B1); PG8_BAR;
            PG8_LDA(At, 0, 1); PG8_STAGE(PG8_SA(0, 0), a2, voffA);
            PG8_BAR; PG8_WAIT_L(0); PG8_MMA(1, 0, At, B0); PG8_BAR; PG8_SCHED;
            PG8_STAGE(PG8_SB(0, 1), b2 + hstepB, voffB);
            PG8_WAIT_V(6); PG8_BAR; PG8_MMA(1, 1, At, B1); PG8_BAR;
            PG8_LDB(B0, 1, 0); PG8_SCHED; PG8_LDA(At, 1, 0); PG8_STAGE(PG8_SA(0, 1), a2 + hstepA, voffA);
            PG8_WAIT_L(8); PG8_BAR; PG8_WAIT_L(0); PG8_MMA(0, 0, At, B0); PG8_BAR; PG8_SCHED;
            PG8_LDB(B1, 1, 1); PG8_STAGE(PG8_SB(1, 0), b3, voffB);
            PG8_BAR; PG8_WAIT_L(0); PG8_MMA(0, 1, At, B1); PG8_BAR;
            PG8_LDA(At, 1, 1); PG8_STAGE(PG8_SA(1, 0), a3, voffA);
            PG8_BAR; PG8_WAIT_L(0); PG8_MMA(1, 0, At, B0); PG8_BAR; PG8_SCHED;
            PG8_STAGE(PG8_SB(1, 1), b3 + hstepB, voffB);
            PG8_WAIT_V(6); PG8_BAR; PG8_MMA(1, 1, At, B1); PG8_BAR;
            }
        }
        if constexpr (ALIGN_EPI) { if (wr == 0) PG8_BAR; }
        E(acc, cur, wr, wc, fr, fq);
        if (!has_next) break;
#pragma unroll
        for (int a = 0; a < 2; ++a)
#pragma unroll
            for (int b = 0; b < 2; ++b)
#pragma unroll
                for (int m = 0; m < 4; ++m)
#pragma unroll
                    for (int n = 0; n < 2; ++n) acc[a][b][m][n] = (f32x4){0.f, 0.f, 0.f, 0.f};
        cur = nxt; cA = nA; cB = nB; ++ui;
        if constexpr (ALIGN_EPI) { if (wr == 1) PG8_BAR; }
    }
    PG8_WAIT_V(0);
    if constexpr (!ALIGN_EPI) { if (wr == 0) PG8_BAR; }
    PG8_BAR;
#undef PG8_SA
#undef PG8_SB
#undef PG8_STAGE
#undef PG8_LDA
#undef PG8_LDB
#undef PG8_MMA
#undef PG8_WAIT_V
#undef PG8_WAIT_L
#undef PG8_BAR
#undef PG8_SCHED
}
}

constexpr int NWAVES = 8;
constexpr int BATCH = 16, SEQ = 2048, DM = 1024, T = BATCH * SEQ, MEML = 256, TM = BATCH * MEML;
constexpr int INW = 5888, DFF = 2816, NGU = 2 * DFF;
constexpr int C_QA = 0, C_KA = 512, C_VA = 640, C_QB = 768, C_KB = 1280, C_VB = 1792, C_QM = 2304, C_G = 2816;
constexpr float EPS = 1e-6f;
constexpr int N_PHASES = 9;

constexpr size_t MiB = 1u << 20;
constexpr size_t WS_CTL = 0, CTL_ZERO_BYTES = 64 * 1024;
constexpr size_t WS_WIN = 1 * MiB, WS_WMKV = 13 * MiB, WS_WBR = 15 * MiB, WS_WOUT = 18 * MiB, WS_WGU = 20 * MiB, WS_WDN = 31 * MiB, WS_BIAS = 37 * MiB;
constexpr size_t WS_MN = 40 * MiB, WS_MKV = 48 * MiB, WS_XN = 56 * MiB  , WS_PROJ = 120 * MiB;
constexpr size_t WS_MIX = 120 * MiB  , WS_XN2 = 248 * MiB, WS_A = 312 * MiB, WS_END = 488 * MiB;
static_assert(WS_PROJ + (size_t)T * INW * 2 <= WS_END && WS_A + (size_t)T * DFF * 2 <= WS_END && WS_XN2 + (size_t)T * DM * 2 <= WS_A && WS_MIX + (size_t)T * DM * 4 <= WS_XN2, "d_ws map");
static_assert(WS_WIN + (size_t)INW * DM * 2 <= WS_WMKV && WS_WGU + (size_t)NGU * DM * 2 <= WS_WDN && WS_WDN + (size_t)DM * DFF * 2 <= WS_BIAS, "d_ws weight map");

constexpr int LDS_BYTES = 147456;

__device__ const unsigned char T5B[128] = {0, 1, 2, 3, 4, 5, 6, 7, 8, 9, 10, 11, 12, 13, 14, 15, 16, 16, 16, 17, 17, 18, 18, 18, 19, 19, 19, 20, 20, 20, 20, 21, 21, 21, 21, 22, 22, 22, 22, 22, 23, 23, 23, 23, 23, 23, 24, 24, 24, 24, 24, 24, 25, 25, 25, 25, 25, 25, 25, 26, 26, 26, 26, 26, 26, 26, 26, 27, 27, 27, 27, 27, 27, 27, 27, 27, 27, 28, 28, 28, 28, 28, 28, 28, 28, 28, 28, 29, 29, 29, 29, 29, 29, 29, 29, 29, 29, 29, 29, 30, 30, 30, 30, 30, 30, 30, 30, 30, 30, 30, 30, 30, 30, 31, 31, 31, 31, 31, 31, 31, 31, 31, 31, 31, 31, 31, 31, 31};

#define LAS __attribute__((address_space(3)))
typedef unsigned short bf16;
typedef unsigned v4u __attribute__((ext_vector_type(4)));
typedef unsigned v2u __attribute__((ext_vector_type(2)));
typedef float f32x4 __attribute__((ext_vector_type(4)));
#define LDS_WAIT() asm volatile("s_waitcnt lgkmcnt(0)" ::: "memory")
__device__ __forceinline__ unsigned f2bf(float f) { unsigned u = __builtin_bit_cast(unsigned, f); return (u + 0x7fffu + ((u >> 16) & 1u)) >> 16; }
__device__ __forceinline__ unsigned pk2(float lo, float hi) { return f2bf(lo) | (f2bf(hi) << 16); }
__device__ __forceinline__ float bflo(unsigned u) { return __builtin_bit_cast(float, u << 16); }
__device__ __forceinline__ float bfhi(unsigned u) { return __builtin_bit_cast(float, u & 0xffff0000u); }
__device__ __forceinline__ float bf1(bf16 h) { return __builtin_bit_cast(float, (unsigned)h << 16); }
__device__ __forceinline__ float wave_sum(float v) {
#pragma unroll
    for (int o = 1; o < 64; o <<= 1) v += __shfl_xor(v, o);
    return v;
}
__device__ __forceinline__ float wave_max(float v) {
#pragma unroll
    for (int o = 1; o < 64; o <<= 1) v = fmaxf(v, __shfl_xor(v, o));
    return v;
}
__device__ __forceinline__ float dot8(v4u a, v4u b) {
    float s = bflo(a.x) * bflo(b.x); s += bfhi(a.x) * bfhi(b.x); s += bflo(a.y) * bflo(b.y); s += bfhi(a.y) * bfhi(b.y);
    s += bflo(a.z) * bflo(b.z); s += bfhi(a.z) * bfhi(b.z); s += bflo(a.w) * bflo(b.w); s += bfhi(a.w) * bfhi(b.w); return s;
}
__device__ __forceinline__ float sigmoidf_(float x) { return 1.0f / (1.0f + __expf(-x)); }

struct Frame {
    LAS unsigned char* lds;
    int tid, lane, wave, G, gw, ngw;
    const float *x, *mem, *ln_mix_pre, *ln_mix_post, *w_in, *sinks, *rel_bias, *ln_mem, *w_mem_kv, *w_br0, *w_br1, *w_br2, *w_out, *ln_ffn_pre, *ln_ffn_post, *w_gate, *w_up, *w_down;
    float* out;
    bf16 *WinT, *WmkvT, *WbrT, *WoutT, *WguT, *WdnT, *MN, *MKV, *XN, *MERGED, *PROJ, *XN2, *AH;
    float *BIAS, *MIX;
};

__device__ __forceinline__ void p0_transpose_item(const float* W, int K, int N, bf16* WT, int drow0, int k0, int n0, LAS float* scr, int lane) {
#pragma unroll 8
    for (int i = 0; i < 32; ++i) { const int kk = 2 * i + (lane >> 5); scr[kk * 33 + (lane & 31)] = W[(size_t)(k0 + kk) * N + n0 + (lane & 31)]; }
    LDS_WAIT(); asm volatile("" ::: "memory");
    const int c = lane & 7;
#pragma unroll
    for (int j = 0; j < 4; ++j) { const int n = (lane >> 3) + 8 * j; const LAS float* s = scr + (8 * c) * 33 + n;
        v4u o; o.x = pk2(s[0 * 33], s[1 * 33]); o.y = pk2(s[2 * 33], s[3 * 33]); o.z = pk2(s[4 * 33], s[5 * 33]); o.w = pk2(s[6 * 33], s[7 * 33]);
        *(v4u*)(WT + (size_t)(drow0 + n) * K + k0 + 8 * c) = o; }
    LDS_WAIT(); asm volatile("" ::: "memory");
}
__device__ __forceinline__ void rms_row_to_bf16(const float* xrow, const float* g, bf16* orow, int lane) {
    const f32x4* xr = (const f32x4*)xrow + lane; const f32x4* gr = (const f32x4*)g + lane;
    f32x4 v[4]; float s = 0.f;
#pragma unroll
    for (int j = 0; j < 4; ++j) { v[j] = xr[64 * j]; s += (v[j].x * v[j].x + v[j].y * v[j].y) + (v[j].z * v[j].z + v[j].w * v[j].w); }
    const float rstd = 1.0f / sqrtf(wave_sum(s) * (1.f / DM) + EPS);
    v2u* o8 = (v2u*)orow + lane;
#pragma unroll
    for (int j = 0; j < 4; ++j) { const f32x4 gg = gr[64 * j]; v2u w; w.x = pk2(v[j].x * rstd * gg.x, v[j].y * rstd * gg.y); w.y = pk2(v[j].z * rstd * gg.z, v[j].w * rstd * gg.w); o8[64 * j] = w; }
}

__device__ __forceinline__ void phase_prologue(Frame& F) {
    LAS float* scr = (LAS float*)(F.lds + F.wave * 16384);
    constexpr int I_IN = (DM / 64) * (INW / 32), I_MKV = (DM / 64) * (DM / 32), I_BR = (512 / 64) * (DM / 32), I_OUT = I_MKV, I_G = (DM / 64) * (DFF / 32), I_D = (DFF / 64) * (DM / 32);
    constexpr int NITEMS = I_IN + I_MKV + 3 * I_BR + I_OUT + 2 * I_G + I_D;
    for (int it = F.gw; it < NITEMS; it += F.ngw) {
        int r = it;
        if (r < I_IN) { const int nb = r % (INW / 32), kb = r / (INW / 32); p0_transpose_item(F.w_in, DM, INW, F.WinT, 32 * nb, 64 * kb, 32 * nb, scr, F.lane); continue; } r -= I_IN;
        if (r < I_MKV) { const int nb = r % (DM / 32), kb = r / (DM / 32); p0_transpose_item(F.w_mem_kv, DM, DM, F.WmkvT, 32 * nb, 64 * kb, 32 * nb, scr, F.lane); continue; } r -= I_MKV;
        if (r < I_BR) { const int nb = r % (DM / 32), kb = r / (DM / 32); p0_transpose_item(F.w_br0, 512, DM, F.WbrT, 32 * nb, 64 * kb, 32 * nb, scr, F.lane); continue; } r -= I_BR;
        if (r < I_BR) { const int nb = r % (DM / 32), kb = r / (DM / 32); p0_transpose_item(F.w_br1, 512, DM, F.WbrT + (size_t)DM * 512, 32 * nb, 64 * kb, 32 * nb, scr, F.lane); continue; } r -= I_BR;
        if (r < I_BR) { const int nb = r % (DM / 32), kb = r / (DM / 32); p0_transpose_item(F.w_br2, 512, DM, F.WbrT + (size_t)2 * DM * 512, 32 * nb, 64 * kb, 32 * nb, scr, F.lane); continue; } r -= I_BR;
        if (r < I_OUT) { const int nb = r % (DM / 32), kb = r / (DM / 32); p0_transpose_item(F.w_out, DM, DM, F.WoutT, 32 * nb, 64 * kb, 32 * nb, scr, F.lane); continue; } r -= I_OUT;
        if (r < I_G) { const int nb = r % (DFF / 32), kb = r / (DFF / 32), n0 = 32 * nb;
            p0_transpose_item(F.w_gate, DM, DFF, F.WguT, (n0 / 128) * 256 + (n0 % 128), 64 * kb, n0, scr, F.lane); continue; } r -= I_G;
        if (r < I_G) { const int nb = r % (DFF / 32), kb = r / (DFF / 32), n0 = 32 * nb;
            p0_transpose_item(F.w_up, DM, DFF, F.WguT, (n0 / 128) * 256 + 128 + (n0 % 128), 64 * kb, n0, scr, F.lane); continue; } r -= I_G;
        { const int nb = r % (DM / 32), kb = r / (DM / 32); p0_transpose_item(F.w_down, DFF, DM, F.WdnT, 32 * nb, 64 * kb, 32 * nb, scr, F.lane); }
    }
    for (int m = F.gw; m < T; m += F.ngw) rms_row_to_bf16(F.x + (size_t)m * DM, F.ln_mix_pre, F.XN + (size_t)m * DM, F.lane);
    for (int m = F.gw; m < TM; m += F.ngw) rms_row_to_bf16(F.mem + (size_t)m * DM, F.ln_mem, F.MN + (size_t)m * DM, F.lane);
    for (int i = blockIdx.x * (NWAVES * 64) + F.tid; i < 128 * 8; i += F.G * NWAVES * 64) F.BIAS[i] = F.rel_bias[(int)T5B[i >> 3] * 8 + (i & 7)];
}

struct SchedProj {
    int G, c; const char *XN, *MN, *WinT, *WmkvT;
    __device__ __forceinline__ bool next(int i, pg8::Unit& u) const {
        const int L = i * G + c; constexpr int N1 = (T / 256) * (INW / 256), N2 = (TM / 256) * (DM / 256);
        if (L < N1) { pg8::tile_of(L, T / 256, INW / 256, u.pm, u.pn); u.z = 0; u.a = XN + (size_t)u.pm * 256 * DM * 2; u.b = WinT + (size_t)u.pn * 256 * DM * 2; return true; }
        if (L < N1 + N2) { const int l = L - N1; u.pm = l >> 2; u.pn = l & 3; u.z = 1; u.a = MN + (size_t)u.pm * 256 * DM * 2; u.b = WmkvT + (size_t)u.pn * 256 * DM * 2; return true; }
        return false;
    }
};
struct EpiProj {
    static constexpr bool PERM = true;
    bf16 *PROJ, *MKV;
    __device__ __forceinline__ void operator()(const pg8::f32x4 (&acc)[2][2][4][2], const pg8::Unit& u, int wr, int wc, int fr, int fq) const {
        bf16* base = u.z ? MKV : PROJ; const int ldc = u.z ? DM : INW; const bool sig = (u.z == 0) && (u.pn * 256 >= C_G);
        const int row0 = u.pm * 256 + wr * 64 + fr, col0 = u.pn * 256 + wc * 32 + 8 * fq;
#pragma unroll
        for (int ai = 0; ai < 2; ++ai)
#pragma unroll
            for (int m = 0; m < 4; ++m) { bf16* rowp = base + (size_t)(row0 + ai * 128 + m * 16) * ldc + col0;
#pragma unroll
                for (int bj = 0; bj < 2; ++bj) { pg8::f32x4 v0 = acc[ai][bj][m][0], v1 = acc[ai][bj][m][1];
                    if (sig) {
#pragma unroll
                        for (int e = 0; e < 4; ++e) { v0[e] = sigmoidf_(v0[e]); v1[e] = sigmoidf_(v1[e]); } }
                    pg8::u32x4 w; w.x = pg8::cvt_pk_bf16(v0[0], v0[1]); w.y = pg8::cvt_pk_bf16(v0[2], v0[3]); w.z = pg8::cvt_pk_bf16(v1[0], v1[1]); w.w = pg8::cvt_pk_bf16(v1[2], v1[3]);
                    *(pg8::u32x4*)(rowp + bj * 128) = w; } }
    }
};
struct SchedMerge {
    int G, c; const char *PROJ, *WbrT;
    __device__ __forceinline__ bool next(int i, pg8::Unit& u) const {
        const int ti = i / 3, z = i - 3 * ti, L = ti * G + c;
        if (L >= (T / 256) * (DM / 256)) return false;
        pg8::tile_of(L, T / 256, DM / 256, u.pm, u.pn); u.z = z;
        const int ycol = z == 0 ? C_QA : (z == 1 ? C_QB : C_QM);
        u.a = PROJ + ((size_t)u.pm * 256 * INW + ycol) * 2; u.b = WbrT + ((size_t)z * DM * 512 + (size_t)u.pn * 256 * 512) * 2; return true;
    }
};
struct EpiMerge {
    static constexpr bool PERM = true;
    const bf16* PROJ; bf16* MERGED;
    __device__ __forceinline__ void operator()(const pg8::f32x4 (&acc)[2][2][4][2], const pg8::Unit& u, int wr, int wc, int fr, int fq) const {
        const int row0 = u.pm * 256 + wr * 64 + fr, col0 = u.pn * 256 + wc * 32 + 8 * fq;
#pragma unroll
        for (int ai = 0; ai < 2; ++ai)
#pragma unroll
            for (int m = 0; m < 4; ++m) { const size_t row = (size_t)(row0 + ai * 128 + m * 16);
#pragma unroll
                for (int bj = 0; bj < 2; ++bj) { const int col = col0 + bj * 128;
                    const pg8::u32x4 gq = *(const pg8::u32x4*)(PROJ + row * INW + C_G + u.z * DM + col);
                    pg8::f32x4 v0 = acc[ai][bj][m][0], v1 = acc[ai][bj][m][1];
                    v0[0] *= bflo(gq.x); v0[1] *= bfhi(gq.x); v0[2] *= bflo(gq.y); v0[3] *= bfhi(gq.y); v1[0] *= bflo(gq.z); v1[1] *= bfhi(gq.z); v1[2] *= bflo(gq.w); v1[3] *= bfhi(gq.w);
                    bf16* mp = MERGED + row * DM + col;
                    if (u.z != 0) { const pg8::u32x4 mq = *(const pg8::u32x4*)mp;
                        v0[0] += bflo(mq.x); v0[1] += bfhi(mq.x); v0[2] += bflo(mq.y); v0[3] += bfhi(mq.y); v1[0] += bflo(mq.z); v1[1] += bfhi(mq.z); v1[2] += bflo(mq.w); v1[3] += bfhi(mq.w); }
                    pg8::u32x4 w; w.x = pg8::cvt_pk_bf16(v0[0], v0[1]); w.y = pg8::cvt_pk_bf16(v0[2], v0[3]); w.z = pg8::cvt_pk_bf16(v1[0], v1[1]); w.w = pg8::cvt_pk_bf16(v1[2], v1[3]);
                    *(pg8::u32x4*)mp = w; } }
    }
};
struct SchedPlain {
    int G, c, nM, nN; const char *A, *Bt; size_t astep, bstep;
    __device__ __forceinline__ bool next(int i, pg8::Unit& u) const {
        const int L = i * G + c; if (L >= nM * nN) return false;
        pg8::tile_of(L, nM, nN, u.pm, u.pn); u.z = 0; u.a = A + (size_t)u.pm * astep; u.b = Bt + (size_t)u.pn * bstep; return true;
    }
};
struct EpiF32 {
    static constexpr bool PERM = false;
    float* C; int ldc;
    __device__ __forceinline__ void operator()(const pg8::f32x4 (&acc)[2][2][4][2], const pg8::Unit& u, int wr, int wc, int fr, int fq) const {
        const int row0 = u.pm * 256 + wr * 64 + fr, col0 = u.pn * 256 + wc * 32 + 4 * fq;
#pragma unroll
        for (int ai = 0; ai < 2; ++ai)
#pragma unroll
            for (int m = 0; m < 4; ++m) { float* rowp = C + (size_t)(row0 + ai * 128 + m * 16) * ldc + col0;
#pragma unroll
                for (int bj = 0; bj < 2; ++bj)
#pragma unroll
                    for (int n = 0; n < 2; ++n) *(pg8::f32x4*)(rowp + bj * 128 + n * 16) = acc[ai][bj][m][n]; }
    }
};
struct EpiSwiGLU {
    static constexpr bool PERM = true;
    bf16* AH;
    __device__ __forceinline__ void operator()(const pg8::f32x4 (&acc)[2][2][4][2], const pg8::Unit& u, int wr, int wc, int fr, int fq) const {
        const int row0 = u.pm * 256 + wr * 64 + fr, col0 = u.pn * 128 + wc * 32 + 8 * fq;
#pragma unroll
        for (int ai = 0; ai < 2; ++ai)
#pragma unroll
            for (int m = 0; m < 4; ++m) { bf16* rowp = AH + (size_t)(row0 + ai * 128 + m * 16) * DFF + col0;
                float o[8];
#pragma unroll
                for (int n = 0; n < 2; ++n)
#pragma unroll
                    for (int e = 0; e < 4; ++e) { const float gv = acc[ai][0][m][n][e], uv = acc[ai][1][m][n][e]; o[4 * n + e] = gv * sigmoidf_(gv) * uv; }
                pg8::u32x4 w; w.x = pg8::cvt_pk_bf16(o[0], o[1]); w.y = pg8::cvt_pk_bf16(o[2], o[3]); w.z = pg8::cvt_pk_bf16(o[4], o[5]); w.w = pg8::cvt_pk_bf16(o[6], o[7]);
                *(pg8::u32x4*)rowp = w; }
    }
};

__device__ __forceinline__ void attn_swa_row(Frame& F, int row, int hq) {
    const int lane = F.lane, t = row % SEQ, kvh = hq >> 2;
    const bf16* qp = F.PROJ + (size_t)row * INW + C_QA + hq * 64;
    v4u q[8];
#pragma unroll
    for (int i = 0; i < 8; ++i) q[i] = *(const v4u*)(qp + 8 * i);
    float sc[2]; bool val[2];
#pragma unroll
    for (int j = 0; j < 2; ++j) { const int dist = lane + 64 * j, s = t - dist; val[j] = s >= 0; sc[j] = -INFINITY;
        if (val[j]) { const bf16* kp = F.PROJ + (size_t)(row - dist) * INW + C_KA + kvh * 64; float a = 0.f;
#pragma unroll
            for (int i = 0; i < 8; ++i) a += dot8(q[i], *(const v4u*)(kp + 8 * i));
            sc[j] = a * 0.125f + F.BIAS[dist * 8 + hq]; } }
    const float sink = F.sinks[hq];
    const float mx = fmaxf(wave_max(fmaxf(sc[0], sc[1])), sink);
    float p0 = val[0] ? __expf(sc[0] - mx) : 0.f, p1 = val[1] ? __expf(sc[1] - mx) : 0.f;
    const float den = wave_sum(p0 + p1) + __expf(sink - mx);
    p0 /= den; p1 /= den;
    float y = 0.f; const int nk = t < 127 ? t + 1 : 128;
    const bf16* vp = F.PROJ + (size_t)row * INW + C_VA + kvh * 64 + lane;
    for (int d = 0; d < nk; ++d) { const float w = __shfl(d < 64 ? p0 : p1, d & 63); y += w * bf1(vp[-(ptrdiff_t)d * INW]); }
    ((bf16*)qp)[lane] = (bf16)f2bf(y);
}
__device__ __forceinline__ void attn_sb_row(Frame& F, int row, int h) {
    const int lane = F.lane, t = row % SEQ;
    const bf16* qp = F.PROJ + (size_t)row * INW + C_QB + h * 64;
    v4u q[8];
#pragma unroll
    for (int i = 0; i < 8; ++i) q[i] = *(const v4u*)(qp + 8 * i);
    float carry = 1.f, y = 0.f;
    for (int base = t - 1; base >= 0 && carry != 0.f; base -= 64) {
        const int s = base - lane; const bool valid = s >= 0;
        float beta = 0.f, c = 1.f;
        if (valid) { const bf16* kp = F.PROJ + (size_t)(row - t + s) * INW + C_KB + h * 64; float a = 0.f;
#pragma unroll
            for (int i = 0; i < 8; ++i) a += dot8(q[i], *(const v4u*)(kp + 8 * i));
            const float z = fmaxf(a * 0.125f, -80.f), e = __expf(-z); beta = 1.0f / (1.0f + e); c = e * beta; }
        float incl = c;
#pragma unroll
        for (int o = 1; o < 64; o <<= 1) { const float tq = __shfl_up(incl, o); if (lane >= o) incl *= tq; }
        float excl = __shfl_up(incl, 1); if (lane == 0) excl = 1.f;
        const float a = beta * excl * carry;
        carry *= __shfl(incl, 63);
        const int nv = base + 1 < 64 ? base + 1 : 64;
        const bf16* vp = F.PROJ + (size_t)(row - t + base) * INW + C_VB + h * 64 + lane;
        for (int j = 0; j < nv; ++j) { const float w = __shfl(a, j); y += w * bf1(vp[-(ptrdiff_t)j * INW]); }
    }
    ((bf16*)qp)[lane] = (bf16)f2bf(y);
}
__device__ __forceinline__ void attn_mem_row(Frame& F, int row, int h) {
    const int lane = F.lane, b = row / SEQ;
    const bf16* qp = F.PROJ + (size_t)row * INW + C_QM + h * 128;
    v4u q[16];
#pragma unroll
    for (int i = 0; i < 16; ++i) q[i] = *(const v4u*)(qp + 8 * i);
    float sc[4];
#pragma unroll
    for (int j = 0; j < 4; ++j) { const bf16* kp = F.MKV + (size_t)(b * MEML + lane + 64 * j) * DM + h * 128; float a = 0.f;
#pragma unroll
        for (int i = 0; i < 16; ++i) a += dot8(q[i], *(const v4u*)(kp + 8 * i));
        sc[j] = a * 0.08838834764831845f; }
    const float mx = wave_max(fmaxf(fmaxf(sc[0], sc[1]), fmaxf(sc[2], sc[3])));
    float p[4]; float ps = 0.f;
#pragma unroll
    for (int j = 0; j < 4; ++j) { p[j] = __expf(sc[j] - mx); ps += p[j]; }
    const float den = wave_sum(ps);
    float y0 = 0.f, y1 = 0.f;
    const bf16* vp = F.MKV + (size_t)(b * MEML) * DM + 512 + h * 128 + lane;
#pragma unroll
    for (int j = 0; j < 4; ++j)
        for (int m = 0; m < 64; ++m) { const float w = __shfl(p[j], m); const bf16* v = vp + (size_t)(64 * j + m) * DM; y0 += w * bf1(v[0]); y1 += w * bf1(v[64]); }
    ((bf16*)qp)[lane] = (bf16)f2bf(y0 / den); ((bf16*)qp)[lane + 64] = (bf16)f2bf(y1 / den);
}
#ifndef ATTN_MFMA_SB
#define ATTN_MFMA_SB 1
#endif
#ifndef ATTN_MFMA_SWA
#define ATTN_MFMA_SWA 1
#endif
#ifndef ATTN_MFMA_MEM
#define ATTN_MFMA_MEM 1
#endif
namespace at {
typedef short bf16x8 __attribute__((ext_vector_type(8)));
typedef float f32x16 __attribute__((ext_vector_type(16)));
typedef short s16x4 __attribute__((ext_vector_type(4)));
typedef float f32x2_t __attribute__((ext_vector_type(2)));
typedef __bf16 bf16x2_t __attribute__((ext_vector_type(2)));
constexpr float LOG2E = 1.4426950408889634f;
constexpr int LDS_V = 0, LDS_SC = 65536, LDS_TB = 65536 + 8 * 256, TB_N = 192;
__device__ __forceinline__ unsigned cvtpk(float lo, float hi) { f32x2_t v = {lo, hi}; bf16x2_t b = __builtin_convertvector(v, bf16x2_t); return __builtin_bit_cast(unsigned, b); }
__device__ __forceinline__ int kperm(int r) { return 16 * ((r >> 2) & 1) + 4 * (r >> 3) + (r & 3); }
__device__ __forceinline__ int crow(int i, int h) { return (i & 3) + 8 * (i >> 2) + 4 * h; }
__device__ __forceinline__ float xhalf(float v) { return __shfl_xor(v, 32); }
#define AT_MFMA(a, b, c) __builtin_amdgcn_mfma_f32_32x32x16_bf16((a), (b), (c), 0, 0, 0)

template <int D> __device__ __forceinline__ void load_q(bf16x8 (&qf)[D / 16], const bf16* Q, size_t pitch, int q0, int lane) {
    const bf16* p = Q + (size_t)(q0 + (lane & 31)) * pitch + 8 * (lane >> 5);
#pragma unroll
    for (int s = 0; s < D / 16; ++s) qf[s] = *(const bf16x8*)(p + 16 * s);
}
template <int D> __device__ __forceinline__ void load_k(bf16x8 (&kf)[D / 16], const bf16* K, size_t pitch, int k0, int lane) {
    const bf16* p = K + (size_t)(k0 + kperm(lane & 31)) * pitch + 8 * (lane >> 5);
#pragma unroll
    for (int s = 0; s < D / 16; ++s) kf[s] = *(const bf16x8*)(p + 16 * s);
}
template <int D> __device__ __forceinline__ f32x16 qk(const bf16x8 (&kf)[D / 16], const bf16x8 (&qf)[D / 16]) {
    f32x16 acc;
#pragma unroll
    for (int i = 0; i < 16; ++i) acc[i] = 0.f;
#pragma unroll
    for (int s = 0; s < D / 16; ++s) acc = AT_MFMA(kf[s], qf[s], acc);
    return acc;
}
template <int D> __device__ __forceinline__ void load_v(v4u (&vr)[D / 16], const bf16* V, size_t pitch, int k0, int lane) {
#pragma unroll
    for (int w = 0; w < D / 16; ++w) { const int ci = lane + 64 * w, kk = ci / (D / 8), c = ci % (D / 8); vr[w] = *(const v4u*)(V + (size_t)(k0 + kk) * pitch + 8 * c); }
}
template <int D> __device__ __forceinline__ int vswz(int kk) { return D == 64 ? (((kk >> 1) & 1) << 2) : ((kk & 3) << 2); }
template <int D> __device__ __forceinline__ void store_v(const v4u (&vr)[D / 16], LAS unsigned char* vl, int lane) {
#pragma unroll
    for (int w = 0; w < D / 16; ++w) { const int ci = lane + 64 * w, kk = ci / (D / 8), c = ci % (D / 8); *(LAS v4u*)(vl + kk * (D * 2) + ((c ^ vswz<D>(kk)) << 4)) = vr[w]; }
}
__device__ __forceinline__ s16x4 vtr(LAS unsigned char* p) { typedef short v4i16_t __attribute__((ext_vector_type(4))); return __builtin_bit_cast(s16x4, __builtin_amdgcn_ds_read_tr16_b64_v4i16((LAS v4i16_t*)p)); }
template <int D> __device__ __forceinline__ void pv(f32x16 (&o)[D / 32], const bf16x8 (&pa)[2], LAS unsigned char* vl, int lane) {
    const int g = lane >> 4, q = (lane & 15) >> 2, p = lane & 3, h = g >> 1;
#pragma unroll
    for (int db = 0; db < D / 32; ++db)
#pragma unroll
        for (int s = 0; s < 2; ++s) {
            s16x4 t[2];
#pragma unroll
            for (int u = 0; u < 2; ++u) { const int kk = 16 * h + 8 * s + 4 * u + q, chunk = db * 4 + 2 * (g & 1) + (p >> 1);
                t[u] = vtr(vl + kk * (D * 2) + ((chunk ^ vswz<D>(kk)) << 4) + (p & 1) * 8); }
            const bf16x8 vf = (bf16x8){t[0][0], t[0][1], t[0][2], t[0][3], t[1][0], t[1][1], t[1][2], t[1][3]};
            o[db] = AT_MFMA(pa[s], vf, o[db]);
        }
}
__device__ __forceinline__ void pack_p(bf16x8 (&pa)[2], const float (&a)[16]) {
#pragma unroll
    for (int s = 0; s < 2; ++s) { v4u w; w.x = cvtpk(a[8 * s], a[8 * s + 1]); w.y = cvtpk(a[8 * s + 2], a[8 * s + 3]); w.z = cvtpk(a[8 * s + 4], a[8 * s + 5]); w.w = cvtpk(a[8 * s + 6], a[8 * s + 7]); pa[s] = __builtin_bit_cast(bf16x8, w); }
}
template <int D> __device__ __forceinline__ void store_o(const f32x16 (&o)[D / 32], bf16* Y, size_t pitch, int q0, int lane, const LAS float* sc) {
    const int d = lane & 31, hh = lane >> 5;
#pragma unroll
    for (int i = 0; i < 16; ++i) { const int qr = crow(i, hh); const float f = sc ? sc[qr] : 1.f; bf16* yp = Y + (size_t)(q0 + qr) * pitch + d;
#pragma unroll
        for (int db = 0; db < D / 32; ++db) yp[db * 32] = (bf16)f2bf(o[db][i] * f); }
}

__device__ __forceinline__ void sb_block(const bf16* Qh, const bf16* Kh, const bf16* Vh, bf16* Yh, int q0, LAS unsigned char* vl, int lane) {
    constexpr int D = 64; constexpr float C1 = 0.125f * LOG2E;
    const int n = lane & 31, h = lane >> 5;
    bf16x8 qf[4]; load_q<D>(qf, Qh, INW, q0, lane);
    f32x16 o[2];
#pragma unroll
    for (int i = 0; i < 16; ++i) { o[0][i] = 0.f; o[1][i] = 0.f; }
    float carry = 1.f;
    bf16x8 kf[4]; v4u vr[4];
    load_k<D>(kf, Kh, INW, q0, lane); load_v<D>(vr, Vh, INW, q0, lane);
    for (int k0 = q0; k0 >= 0; k0 -= 32) {
        const f32x16 S = qk<D>(kf, qf);
        store_v<D>(vr, vl, lane);
        if (k0 >= 32) { load_k<D>(kf, Kh, INW, k0 - 32, lane); load_v<D>(vr, Vh, INW, k0 - 32, lane); }
        const bool diag = (k0 == q0);
        float bp[16]; float P = 1.f;
#pragma unroll
        for (int i = 15; i >= 0; --i) {
            const float z = fmaxf(S[i] * C1, -100.f), e = __builtin_amdgcn_exp2f(-z);
            float b = __builtin_amdgcn_rcpf(1.0f + e), c = e * b;
            if (diag && (16 * h + i >= n)) { b = 0.f; c = 1.f; }
            bp[i] = b * P; P *= c;
        }
        const float To = xhalf(P);
        const float cl = h ? carry : carry * To;
        float a[16];
#pragma unroll
        for (int i = 0; i < 16; ++i) a[i] = bp[i] * cl;
        carry = carry * P * To;
        bf16x8 pa[2]; pack_p(pa, a);
        pv<D>(o, pa, vl, lane);
        if (__ballot(carry != 0.f) == 0ull) break;
    }
    store_o<D>(o, Yh, INW, q0, lane, nullptr);
}

__device__ __forceinline__ void swa_block(const bf16* Qh, const bf16* Kh, const bf16* Vh, bf16* Yh, int q0, float sink2, const LAS float* tb  , LAS unsigned char* vl, LAS float* sc, int lane) {
    constexpr int D = 64; constexpr float C1 = 0.125f * LOG2E;
    const int n = lane & 31, h = lane >> 5;
    bf16x8 qf[4]; load_q<D>(qf, Qh, INW, q0, lane);
    const int klo = q0 >= 128 ? q0 - 128 : 0;
    bf16x8 kf[4];
    float m = sink2;
    for (int k0 = klo; k0 <= q0; k0 += 32) {
        load_k<D>(kf, Kh, INW, k0, lane);
        const f32x16 S = qk<D>(kf, qf);
        const int dl = q0 - k0; const LAS float* tp = tb + (dl + n - 16 * h + 32 - 15);
#pragma unroll
        for (int i = 0; i < 16; ++i) { const int dist = dl + n - 16 * h - i; const float sv = S[i] * C1 + tp[15 - i]; if (dist >= 0 && dist < 128) m = fmaxf(m, sv); }
    }
    m = fmaxf(m, xhalf(m));
    f32x16 o[2];
#pragma unroll
    for (int i = 0; i < 16; ++i) { o[0][i] = 0.f; o[1][i] = 0.f; }
    float l = 0.f; v4u vr[4];
    for (int k0 = klo; k0 <= q0; k0 += 32) {
        load_k<D>(kf, Kh, INW, k0, lane); load_v<D>(vr, Vh, INW, k0, lane);
        const f32x16 S = qk<D>(kf, qf);
        store_v<D>(vr, vl, lane);
        const int dl = q0 - k0; const LAS float* tp = tb + (dl + n - 16 * h + 32 - 15);
        float a[16];
#pragma unroll
        for (int i = 0; i < 16; ++i) { const int dist = dl + n - 16 * h - i; const float sv = S[i] * C1 + tp[15 - i]; a[i] = (dist >= 0 && dist < 128) ? __builtin_amdgcn_exp2f(sv - m) : 0.f; l += a[i]; }
        bf16x8 pa[2]; pack_p(pa, a);
        pv<D>(o, pa, vl, lane);
    }
    l += xhalf(l); l += __builtin_amdgcn_exp2f(sink2 - m);
    if (h == 0) sc[n] = 1.0f / l;
    LDS_WAIT();
    store_o<D>(o, Yh, INW, q0, lane, sc);
    LDS_WAIT();
}

__device__ __forceinline__ void mem_block(const bf16* Qh, const bf16* Kh, const bf16* Vh, bf16* Yh, int q0, LAS unsigned char* vl, LAS float* sc, int lane) {
    constexpr int D = 128; constexpr float C1 = 0.08838834764831845f * LOG2E;
    const int n = lane & 31, h = lane >> 5;
    bf16x8 qf[8]; load_q<D>(qf, Qh, INW, q0, lane);
    bf16x8 kf[8];
    float m = -INFINITY;
    for (int k0 = 0; k0 < MEML; k0 += 32) {
        load_k<D>(kf, Kh, DM, k0, lane);
        const f32x16 S = qk<D>(kf, qf);
#pragma unroll
        for (int i = 0; i < 16; ++i) m = fmaxf(m, S[i]);
    }
    m = fmaxf(m, xhalf(m)) * C1;
    f32x16 o[4];
#pragma unroll
    for (int i = 0; i < 16; ++i) { o[0][i] = 0.f; o[1][i] = 0.f; o[2][i] = 0.f; o[3][i] = 0.f; }
    float l = 0.f; v4u vr[8];
    for (int k0 = 0; k0 < MEML; k0 += 32) {
        load_k<D>(kf, Kh, DM, k0, lane); load_v<D>(vr, Vh, DM, k0, lane);
        const f32x16 S = qk<D>(kf, qf);
        store_v<D>(vr, vl, lane);
        float a[16];
#pragma unroll
        for (int i = 0; i < 16; ++i) { a[i] = __builtin_amdgcn_exp2f(S[i] * C1 - m); l += a[i]; }
        bf16x8 pa[2]; pack_p(pa, a);
        pv<D>(o, pa, vl, lane);
    }
    l += xhalf(l);
    if (h == 0) sc[n] = 1.0f / l;
    LDS_WAIT();
    store_o<D>(o, Yh, INW, q0, lane, sc);
    LDS_WAIT();
    (void)n;
}
}

__device__ __forceinline__ void phase_attention(Frame& F) {
    const int c = (int)blockIdx.x, lane = F.lane;
    const int myid = ((((c >> 3) * NWAVES) + F.wave) << 3) | (c & 7);
    LAS unsigned char* vl = F.lds + at::LDS_V + F.wave * 8192;
    LAS float* sc = (LAS float*)(F.lds + at::LDS_SC) + F.wave * 64;
    LAS float* tb = (LAS float*)(F.lds + at::LDS_TB);
    for (int i = F.tid; i < 8 * at::TB_N; i += NWAVES * 64) { const int hq = i / at::TB_N, dist = i % at::TB_N - 32; tb[i] = (dist >= 0 && dist < 128) ? F.BIAS[dist * 8 + hq] * at::LOG2E : 0.f; }
    __syncthreads();
#if ATTN_MFMA_SB
    for (int t = myid; t < 128 * 32; t += F.ngw) {
        const int x = t & 7, rest = t >> 3, pp = rest >> 5, j = rest & 31, pair = x + 8 * pp, b = pair >> 3, h = pair & 7;
        const bf16* base = F.PROJ + (size_t)b * SEQ * INW + h * 64;
        at::sb_block(base + C_QB, base + C_KB, base + C_VB, (bf16*)base + C_QB, 32 * (63 - j), vl, lane);
        at::sb_block(base + C_QB, base + C_KB, base + C_VB, (bf16*)base + C_QB, 32 * j, vl, lane);
    }
#else
    for (int it = F.gw; it < T * 8; it += F.ngw) attn_sb_row(F, it >> 3, it & 7);
#endif
#if ATTN_MFMA_MEM
    for (int t = myid; t < 64 * 64; t += F.ngw) {
        const int x = t & 7, rest = t >> 3, pp = rest >> 6, qb = rest & 63, pair = x + 8 * pp, b = pair >> 2, h = pair & 3;
        const bf16* qbase = F.PROJ + (size_t)b * SEQ * INW + C_QM + h * 128; const bf16* kbase = F.MKV + (size_t)b * MEML * DM + h * 128;
        at::mem_block(qbase, kbase, kbase + 512, (bf16*)qbase, 32 * qb, vl, sc, lane);
    }
#else
    for (int it = F.gw; it < T * 4; it += F.ngw) attn_mem_row(F, it >> 2, it & 3);
#endif
#if ATTN_MFMA_SWA
    for (int t = myid; t < 32 * 256; t += F.ngw) {
        const int x = t & 7, rest = t >> 3, pi = rest >> 8, w = rest & 255, g = w >> 6, qb = w & 63, pair = x + 8 * pi, b = pair >> 1, kvh = pair & 1, hq = kvh * 4 + g;
        const bf16* base = F.PROJ + (size_t)b * SEQ * INW;
        at::swa_block(base + C_QA + hq * 64, base + C_KA + kvh * 64, base + C_VA + kvh * 64, (bf16*)base + C_QA + hq * 64, 32 * qb, F.sinks[hq] * at::LOG2E, tb + hq * at::TB_N, vl, sc, lane);
    }
#else
    for (int it = F.gw; it < T * 8; it += F.ngw) attn_swa_row(F, it >> 3, it & 7);
#endif
}

__device__ __forceinline__ void phase_norm1(Frame& F) {
    for (int m = F.gw; m < T; m += F.ngw) {
        const f32x4* mr = (const f32x4*)(F.MIX + (size_t)m * DM) + F.lane; const f32x4* xr = (const f32x4*)(F.x + (size_t)m * DM) + F.lane;
        const f32x4* g1 = (const f32x4*)F.ln_mix_post + F.lane; const f32x4* g2 = (const f32x4*)F.ln_ffn_pre + F.lane;
        f32x4 v[4]; float s = 0.f;
#pragma unroll
        for (int j = 0; j < 4; ++j) { v[j] = mr[64 * j]; s += (v[j].x * v[j].x + v[j].y * v[j].y) + (v[j].z * v[j].z + v[j].w * v[j].w); }
        const float rstd = 1.0f / sqrtf(wave_sum(s) * (1.f / DM) + EPS);
        float s2 = 0.f; f32x4* orow = (f32x4*)(F.out + (size_t)m * DM) + F.lane;
#pragma unroll
        for (int j = 0; j < 4; ++j) { v[j] = xr[64 * j] + v[j] * rstd * g1[64 * j]; orow[64 * j] = v[j]; s2 += (v[j].x * v[j].x + v[j].y * v[j].y) + (v[j].z * v[j].z + v[j].w * v[j].w); }
        const float rstd2 = 1.0f / sqrtf(wave_sum(s2) * (1.f / DM) + EPS);
        v2u* o8 = (v2u*)(F.XN2 + (size_t)m * DM) + F.lane;
#pragma unroll
        for (int j = 0; j < 4; ++j) { const f32x4 gg = g2[64 * j]; v2u w; w.x = pk2(v[j].x * rstd2 * gg.x, v[j].y * rstd2 * gg.y); w.y = pk2(v[j].z * rstd2 * gg.z, v[j].w * rstd2 * gg.w); o8[64 * j] = w; }
    }
}
__device__ __forceinline__ void phase_norm2(Frame& F) {
    for (int m = F.gw; m < T; m += F.ngw) {
        const f32x4* fr = (const f32x4*)(F.MIX + (size_t)m * DM) + F.lane; f32x4* orow = (f32x4*)(F.out + (size_t)m * DM) + F.lane;
        const f32x4* g1 = (const f32x4*)F.ln_ffn_post + F.lane;
        f32x4 v[4]; float s = 0.f;
#pragma unroll
        for (int j = 0; j < 4; ++j) { v[j] = fr[64 * j]; s += (v[j].x * v[j].x + v[j].y * v[j].y) + (v[j].z * v[j].z + v[j].w * v[j].w); }
        const float rstd = 1.0f / sqrtf(wave_sum(s) * (1.f / DM) + EPS);
#pragma unroll
        for (int j = 0; j < 4; ++j) orow[64 * j] = orow[64 * j] + v[j] * rstd * g1[64 * j];
    }
}

struct Args { const float* in[18]; float* out; unsigned char* ws; int ph_lo, ph_hi; };
__global__ void __launch_bounds__(NWAVES * 64, 2) mk_fwd(Args args) {
    extern __shared__ __attribute__((aligned(16))) unsigned char lds[];
    Frame F;
    F.lds = (LAS unsigned char*)lds;
    F.tid = threadIdx.x; F.lane = F.tid & 63; F.wave = __builtin_amdgcn_readfirstlane(F.tid >> 6);
    F.G = gridDim.x; F.gw = blockIdx.x * NWAVES + F.wave; F.ngw = F.G * NWAVES;
    unsigned char* ws = args.ws;
    F.x = args.in[0]; F.mem = args.in[1]; F.ln_mix_pre = args.in[2]; F.ln_mix_post = args.in[3]; F.w_in = args.in[4]; F.sinks = args.in[5]; F.rel_bias = args.in[6]; F.ln_mem = args.in[7];
    F.w_mem_kv = args.in[8]; F.w_br0 = args.in[9]; F.w_br1 = args.in[10]; F.w_br2 = args.in[11]; F.w_out = args.in[12]; F.ln_ffn_pre = args.in[13]; F.ln_ffn_post = args.in[14];
    F.w_gate = args.in[15]; F.w_up = args.in[16]; F.w_down = args.in[17]; F.out = args.out;
    F.WinT = (bf16*)(ws + WS_WIN); F.WmkvT = (bf16*)(ws + WS_WMKV); F.WbrT = (bf16*)(ws + WS_WBR); F.WoutT = (bf16*)(ws + WS_WOUT); F.WguT = (bf16*)(ws + WS_WGU); F.WdnT = (bf16*)(ws + WS_WDN);
    F.BIAS = (float*)(ws + WS_BIAS); F.MN = (bf16*)(ws + WS_MN); F.MKV = (bf16*)(ws + WS_MKV); F.XN = (bf16*)(ws + WS_XN); F.MERGED = (bf16*)(ws + WS_XN); F.PROJ = (bf16*)(ws + WS_PROJ);
    F.MIX = (float*)(ws + WS_MIX); F.XN2 = (bf16*)(ws + WS_XN2); F.AH = (bf16*)(ws + WS_A);
    const int lo = args.ph_lo, hi = args.ph_hi;
#define IN(k) (lo <= (k) && (k) < hi)
#define SEAM(k) do { if (IN(k) && IN((k) + 1)) { cg::this_grid().sync(); } } while (0)
    const int c = (int)blockIdx.x;

    if (IN(0)) { phase_prologue(F); }
    SEAM(0);
    if (IN(1)) {
        pg8::Gemm g{DM, DM, DM}; SchedProj S{F.G, c, (const char*)F.XN, (const char*)F.MN, (const char*)F.WinT, (const char*)F.WmkvT}; EpiProj E{F.PROJ, F.MKV};
        pg8::gemm_phase<EpiProj, SchedProj, true, true>(F.lds, g, S, E);
    }
    SEAM(1);
    if (IN(2)) { phase_attention(F); }
    SEAM(2);
    if (IN(3)) {
        pg8::Gemm g{INW, 512, 512}; SchedMerge S{F.G, c, (const char*)F.PROJ, (const char*)F.WbrT}; EpiMerge E{F.PROJ, F.MERGED};
        pg8::gemm_phase<EpiMerge, SchedMerge, true, true>(F.lds, g, S, E);
    }
    SEAM(3);
    if (IN(4)) {
        pg8::Gemm g{DM, DM, DM}; SchedPlain S{F.G, c, T / 256, DM / 256, (const char*)F.MERGED, (const char*)F.WoutT, (size_t)256 * DM * 2, (size_t)256 * DM * 2}; EpiF32 E{F.MIX, DM};
        pg8::gemm_phase<EpiF32, SchedPlain, true, true>(F.lds, g, S, E);
    }
    SEAM(4);
    if (IN(5)) { phase_norm1(F); }
    SEAM(5);
    if (IN(6)) {
        pg8::Gemm g{DM, DM, DM}; SchedPlain S{F.G, c, T / 256, NGU / 256, (const char*)F.XN2, (const char*)F.WguT, (size_t)256 * DM * 2, (size_t)256 * DM * 2}; EpiSwiGLU E{F.AH};
        pg8::gemm_phase<EpiSwiGLU, SchedPlain, true, true>(F.lds, g, S, E);
    }
    SEAM(6);
    if (IN(7)) {
        pg8::Gemm g{DFF, DFF, DFF}; SchedPlain S{F.G, c, T / 256, DM / 256, (const char*)F.AH, (const char*)F.WdnT, (size_t)256 * DFF * 2, (size_t)256 * DFF * 2}; EpiF32 E{F.MIX, DM};
        pg8::gemm_phase<EpiF32, SchedPlain, true, true>(F.lds, g, S, E);
    }
    SEAM(7);
    if (IN(8)) { phase_norm2(F); }
#undef IN
#undef SEAM
}

extern "C" void kernel_launch(void* const* d_in, const int* in_sizes, int n_in, void* d_out, int out_size, void* d_ws, size_t ws_size, hipStream_t stream) {
    static int grid = 0;
    if (grid == 0) {
        if (n_in != 18 || in_sizes[0] != T * DM || out_size != T * DM || ws_size < WS_END) { fprintf(stderr, "kernel_launch: unexpected shapes: n_in %d in0 %d out %d ws %zu (need %zu)\n", n_in, n_in > 0 ? in_sizes[0] : -1, out_size, ws_size, (size_t)WS_END); grid = -1; return; }
        int dev = 0, cus = 0, per_cu = 0;
        if (hipGetDevice(&dev) != hipSuccess || hipDeviceGetAttribute(&cus, hipDeviceAttributeMultiprocessorCount, dev) != hipSuccess) { grid = -1; return; }
        if (hipFuncSetAttribute((const void*)mk_fwd, hipFuncAttributeMaxDynamicSharedMemorySize, LDS_BYTES) != hipSuccess) { fprintf(stderr, "kernel_launch: hipFuncSetAttribute failed\n"); grid = -1; return; }
        if (hipOccupancyMaxActiveBlocksPerMultiprocessor(&per_cu, (const void*)mk_fwd, NWAVES * 64, LDS_BYTES) != hipSuccess || per_cu < 1) { fprintf(stderr, "kernel_launch: occupancy query says %d\n", per_cu); per_cu = 1; }
        (void)hipGetLastError();
        grid = cus;
    }
    if (grid < 0) return;
    Args a{};
    for (int i = 0; i < 18; ++i) a.in[i] = (const float*)d_in[i];
    a.out = (float*)d_out; a.ws = (unsigned char*)d_ws;
#if MK_N_LAUNCHES == 1
    a.ph_lo = 0; a.ph_hi = N_PHASES;
    void* kargs[] = {&a};
    hipError_t e = hipLaunchCooperativeKernel((const void*)mk_fwd, dim3(grid), dim3(NWAVES * 64), kargs, LDS_BYTES, stream);
    if (e != hipSuccess) fprintf(stderr, "kernel_launch: cooperative launch failed: %s (grid %d)\n", hipGetErrorString(e), grid);
#else
    for (int p = 0; p < N_PHASES; ++p) {
        a.ph_lo = p; a.ph_hi = p + 1;
        hipLaunchKernelGGL(mk_fwd, dim3(grid), dim3(NWAVES * 64), LDS_BYTES, stream, a);
    }
#endif
}
```

```cpp
#include <hip/hip_runtime.h>
#include <hip/hip_cooperative_groups.h>
#include <cstdio>
#include <cstdint>
namespace cg = cooperative_groups;

#ifndef MK_N_LAUNCHES
#define MK_N_LAUNCHES 1
#endif

namespace pg8 {
#define PG8_LAS __attribute__((address_space(3)))
typedef unsigned short bf16_t;
typedef short bf16x8 __attribute__((ext_vector_type(8)));
typedef float f32x4 __attribute__((ext_vector_type(4)));
typedef unsigned u32x4 __attribute__((ext_vector_type(4)));
constexpr int BM = 256, BK = 64, HALF = 128, HTB = HALF * BK * 2  , STAGE_BYTES = 8 * HTB, NXCD = 8, WGM = 8;

__host__ __device__ __forceinline__ int lds_byte(int r, int c) { const int st = (r >> 4) * 2 + (c >> 5), rr = r & 15, cc = c & 31, ob = rr * 64 + cc * 2; return st * 1024 + (ob ^ (((ob >> 9) & 1) << 5)); }
__host__ __device__ __forceinline__ void stage_rc(int b, int& R, int& C) { const int st = b / 1024, sb = b % 1024, swz = sb ^ (((sb >> 9) & 1) << 5); R = (st >> 1) * 16 + swz / 64; C = (st & 1) * 32 + (swz % 64) / 2; }
__host__ __device__ __forceinline__ int perm32(int rho) { const int n = rho >> 4, i = rho & 15; return 8 * (i >> 2) + 4 * n + (i & 3); }

struct Unit { int pm, pn, z; const char* a; const char* b; };
struct Gemm { int lda, ldb, K; };

__device__ __forceinline__ void tile_of(int L, int nM, int nN, int& pm, int& pn) {
    const int nwg = nM * nN; int wgid = L;
    { const int q = nwg / NXCD, r = nwg % NXCD, xcd = wgid % NXCD, off = wgid / NXCD; wgid = (xcd < r ? xcd * (q + 1) : r * (q + 1) + (xcd - r) * q) + off; }
    const int nig = WGM * nN, gid = wgid / nig, fm = gid * WGM, gsz = (nM - fm) < WGM ? (nM - fm) : WGM;
    pm = fm + ((wgid % nig) % gsz); pn = (wgid % nig) / gsz;
}

__device__ __forceinline__ unsigned cvt_pk_bf16(float lo, float hi) { unsigned r; asm volatile("v_cvt_pk_bf16_f32 %0, %1, %2" : "=v"(r) : "v"(lo), "v"(hi)); return r; }

template <class Epi, class Sched, bool ALIGN_EPI = false, bool SP2 = false>
__device__ __forceinline__ void gemm_phase(PG8_LAS unsigned char* lds, const Gemm g, const Sched& S, const Epi& E) {
    const int tid = threadIdx.x, wid = __builtin_amdgcn_readfirstlane(tid >> 6), lane = tid & 63, wr = wid >> 2, wc = wid & 3, fr = lane & 15, fq = lane >> 4;
    const int K = g.K, nt = K / BK;
    unsigned voffA[2], voffB[2];
#pragma unroll
    for (int i = 0; i < 2; ++i) { int R, C; stage_rc(tid * 16 + i * 8192, R, C); const int Rb = Epi::PERM ? ((R & ~31) + perm32(R & 31)) : R;
        voffA[i] = (unsigned)(R * g.lda + C) * 2u; voffB[i] = (unsigned)(Rb * g.ldb + C) * 2u; }
    const size_t kstep = (size_t)(BK * 2);
    const size_t hstepA = (size_t)HALF * g.lda * 2, hstepB = (size_t)HALF * g.ldb * 2;
    const unsigned ldsw = (unsigned)wid * 1024u;
    const int aoff = lds_byte(wr * 64 + fr, fq * 8), boff = lds_byte(wc * 32 + fr, fq * 8);
#define PG8_SA(b, h) (((b) * 2 + (h)) * HTB)
#define PG8_SB(b, h) ((4 + (b) * 2 + (h)) * HTB)
#define PG8_STAGE(bufoff, gbase, voff) do { _Pragma("unroll") for (int _i = 0; _i < 2; ++_i) \
        __builtin_amdgcn_global_load_lds((const unsigned*)((const char*)(gbase) + (voff)[_i]), (PG8_LAS unsigned*)(lds + (bufoff) + ldsw + _i * 8192), 16, 0, 0); } while (0)
#define PG8_LDA(dst, b, h) do { _Pragma("unroll") for (int m = 0; m < 4; ++m) _Pragma("unroll") for (int k = 0; k < 2; ++k) dst[m][k] = *(const PG8_LAS bf16x8*)(lds + PG8_SA(b, h) + aoff + m * 2048 + k * 1024); } while (0)
#define PG8_LDB(dst, b, h) do { _Pragma("unroll") for (int n = 0; n < 2; ++n) _Pragma("unroll") for (int k = 0; k < 2; ++k) dst[n][k] = *(const PG8_LAS bf16x8*)(lds + PG8_SB(b, h) + boff + n * 2048 + k * 1024); } while (0)
#define PG8_MMA(ai, bj, At, Bt) do { __builtin_amdgcn_s_setprio(1); _Pragma("unroll") for (int m = 0; m < 4; ++m) _Pragma("unroll") for (int n = 0; n < 2; ++n) _Pragma("unroll") for (int k = 0; k < 2; ++k) \
        acc[ai][bj][m][n] = __builtin_amdgcn_mfma_f32_16x16x32_bf16(Bt[n][k], At[m][k], acc[ai][bj][m][n], 0, 0, 0); __builtin_amdgcn_s_setprio(0); } while (0)
#define PG8_WAIT_V(n) asm volatile("s_waitcnt vmcnt(" #n ")" ::: "memory")
#define PG8_WAIT_L(n) asm volatile("s_waitcnt lgkmcnt(" #n ")" ::: "memory")
#define PG8_BAR __builtin_amdgcn_s_barrier()
#define PG8_SCHED __builtin_amdgcn_sched_barrier(0)
    Unit cur, nxt; int ui = 0;
    if (!S.next(0, cur)) return;
    f32x4 acc[2][2][4][2];
#pragma unroll
    for (int a = 0; a < 2; ++a)
#pragma unroll
        for (int b = 0; b < 2; ++b)
#pragma unroll
            for (int m = 0; m < 4; ++m)
#pragma unroll
                for (int n = 0; n < 2; ++n) acc[a][b][m][n] = (f32x4){0.f, 0.f, 0.f, 0.f};
    bf16x8 At[4][2], B0[2][2], B1[2][2];
    const char* cA = cur.a; const char* cB = cur.b;
    if constexpr (SP2) {
        PG8_STAGE(PG8_SB(0, 0), cB, voffB); PG8_STAGE(PG8_SB(0, 1), cB + hstepB, voffB); PG8_STAGE(PG8_SA(0, 0), cA, voffA); PG8_STAGE(PG8_SA(0, 1), cA + hstepA, voffA);
        if (wr == 1) PG8_BAR;
        PG8_WAIT_V(2); PG8_BAR;
        PG8_STAGE(PG8_SB(1, 0), cB + kstep, voffB); PG8_STAGE(PG8_SA(1, 0), cA + kstep, voffA); PG8_STAGE(PG8_SB(1, 1), cB + hstepB + kstep, voffB);
        PG8_WAIT_V(6); PG8_BAR;
    } else {
        PG8_STAGE(PG8_SB(0, 0), cB, voffB); PG8_STAGE(PG8_SA(0, 0), cA, voffA); PG8_STAGE(PG8_SB(0, 1), cB + hstepB, voffB); PG8_STAGE(PG8_SA(0, 1), cA + hstepA, voffA);
        if (wr == 1) PG8_BAR;
        PG8_WAIT_V(4); PG8_BAR;
        PG8_STAGE(PG8_SB(1, 0), cB + kstep, voffB); PG8_STAGE(PG8_SA(1, 0), cA + kstep, voffA); PG8_STAGE(PG8_SB(1, 1), cB + hstepB + kstep, voffB);
        PG8_WAIT_V(6); PG8_BAR;
    }
    for (;;) {
        const bool has_next = S.next(ui + 1, nxt);
        const char* nA = has_next ? nxt.a : cA; const char* nB = has_next ? nxt.b : cB;
        for (int t = 0; t < nt; t += 2) {
            const bool last = (t == nt - 2);
            const char* a1 = cA + (size_t)(t + 1) * kstep;
            const char* a2 = last ? nA : cA + (size_t)(t + 2) * kstep; const char* b2 = last ? nB : cB + (size_t)(t + 2) * kstep;
            const char* a3 = a2 + kstep; const char* b3 = b2 + kstep;
            if constexpr (SP2) {
            PG8_LDB(B0, 0, 0); PG8_LDB(B1, 0, 1); PG8_SCHED; PG8_LDA(At, 0, 0); PG8_STAGE(PG8_SA(1, 1), a1 + hstepA, voffA);
            PG8_WAIT_V(8); PG8_WAIT_L(0); PG8_BAR; PG8_MMA(0, 0, At, B0); PG8_MMA(0, 1, At, B1); PG8_BAR; PG8_SCHED;
            PG8_LDA(At, 0, 1); PG8_STAGE(PG8_SB(0, 0), b2, voffB); PG8_STAGE(PG8_SB(0, 1), b2 + hstepB, voffB); PG8_STAGE(PG8_SA(0, 0), a2, voffA);
            PG8_WAIT_V(8); PG8_WAIT_L(0); PG8_BAR; PG8_MMA(1, 0, At, B0); PG8_MMA(1, 1, At, B1); PG8_BAR; PG8_SCHED;
            PG8_LDB(B0, 1, 0); PG8_LDB(B1, 1, 1); PG8_SCHED; PG8_LDA(At, 1, 0); PG8_STAGE(PG8_SA(0, 1), a2 + hstepA, voffA);
            PG8_WAIT_V(8); PG8_WAIT_L(0); PG8_BAR; PG8_MMA(0, 0, At, B0); PG8_MMA(0, 1, At, B1); PG8_BAR; PG8_SCHED;
            PG8_LDA(At, 1, 1); PG8_STAGE(PG8_SB(1, 0), b3, voffB); PG8_STAGE(PG8_SB(1, 1), b3 + hstepB, voffB); PG8_STAGE(PG8_SA(1, 0), a3, voffA);
            PG8_WAIT_V(8); PG8_WAIT_L(0); PG8_BAR; PG8_MMA(1, 0, At, B0); PG8_MMA(1, 1, At, B1); PG8_BAR; PG8_SCHED;
            } else {
            PG8_LDB(B0, 0, 0); PG8_SCHED; PG8_LDA(At, 0, 0); PG8_STAGE(PG8_SA(1, 1), a1 + hstepA, voffA);
            PG8_WAIT_L(8); PG8_BAR; PG8_WAIT_L(0); PG8_MMA(0, 0, At, B0); PG8_BAR; PG8_SCHED;
            PG8_LDB(B1, 0, 1); PG8_STAGE(PG8_SB(0, 0), b2, voffB);
            PG8_BAR; PG8_WAIT_L(0); PG8_MMA(0, 1, At, B1); PG8_BAR;
            PG8_LDA(At, 0, 1); PG8_STAGE(PG8_SA(0, 0), a2, voffA);
            PG8_BAR; PG8_WAIT_L(0); PG8_MMA(1, 0, At, B0); PG8_BAR; PG8_SCHED;
            PG8_STAGE(PG8_SB(0, 1), b2 + hstepB, voffB);
            PG8_WAIT_V(6); PG8_BAR; PG8_MMA(1, 1, At, B1); PG8_BAR;
            PG8_LDB(B0, 1, 0); PG8_SCHED; PG8_LDA(At, 1, 0); PG8_STAGE(PG8_SA(0, 1), a2 + hstepA, voffA);
            PG8_WAIT_L(8); PG8_BAR; PG8_WAIT_L(0); PG8_MMA(0, 0, At, B0); PG8_BAR; PG8_SCHED;
            PG8_LDB(B1, 1, 1); PG8_STAGE(PG8_SB(1, 0), b3, voffB);
            PG8_BAR; PG8_WAIT_L(0); PG8_MMA(0, 1, At, B1); PG8_BAR;
            PG8_LDA(At, 1, 1); PG8_STAGE(PG8_SA(1, 0), a3, voffA);
            PG8_BAR; PG8_WAIT_L(0); PG8_MMA(1, 0, At, B0); PG8_BAR; PG8_SCHED;
            PG8_STAGE(PG8_SB(1, 1), b3 + hstepB, voffB);
            PG8_WAIT_V(6); PG8_BAR; PG8_MMA(1, 1, At, B1); PG8_BAR;
            }
        }
        if constexpr (ALIGN_EPI) { if (wr == 0) PG8_BAR; }
        E(acc, cur, wr, wc, fr, fq);
        if (!has_next) break;
#pragma unroll
        for (int a = 0; a < 2; ++a)
#pragma unroll
            for (int b = 0; b < 2; ++b)
#pragma unroll
                for (int m = 0; m < 4; ++m)
#pragma unroll
                    for (int n = 0; n < 2; ++n) acc[a][b][m][n] = (f32x4){0.f, 0.f, 0.f, 0.f};
        cur = nxt; cA = nA; cB = nB; ++ui;
        if constexpr (ALIGN_EPI) { if (wr == 1) PG8_BAR; }
    }
    PG8_WAIT_V(0);
    if constexpr (!ALIGN_EPI) { if (wr == 0) PG8_BAR; }
    PG8_BAR;
#undef PG8_SA
#undef PG8_SB
#undef PG8_STAGE
#undef PG8_LDA
#undef PG8_LDB
#undef PG8_MMA
#undef PG8_WAIT_V
#undef PG8_WAIT_L
#undef PG8_BAR
#undef PG8_SCHED
}
}

constexpr int NWAVES = 8;
constexpr int BATCH = 16, SEQ = 2048, DM = 1024, T = BATCH * SEQ, MEML = 256, TM = BATCH * MEML;
constexpr int INW = 5888, DFF = 2816, NGU = 2 * DFF;
constexpr int C_QA = 0, C_KA = 512, C_VA = 640, C_QB = 768, C_KB = 1280, C_VB = 1792, C_QM = 2304, C_G = 2816;
constexpr float EPS = 1e-6f;
constexpr int N_PHASES = 9;

constexpr size_t MiB = 1u << 20;
constexpr size_t WS_CTL = 0, CTL_ZERO_BYTES = 64 * 1024;
constexpr size_t WS_WIN = 1 * MiB, WS_WMKV = 13 * MiB, WS_WBR = 15 * MiB, WS_WOUT = 18 * MiB, WS_WGU = 20 * MiB, WS_WDN = 31 * MiB, WS_BIAS = 37 * MiB;
constexpr size_t WS_MN = 40 * MiB, WS_MKV = 48 * MiB, WS_XN = 56 * MiB  , WS_PROJ = 120 * MiB;
constexpr size_t WS_MIX = 120 * MiB  , WS_XN2 = 248 * MiB, WS_A = 312 * MiB, WS_END = 488 * MiB;
static_assert(WS_PROJ + (size_t)T * INW * 2 <= WS_END && WS_A + (size_t)T * DFF * 2 <= WS_END && WS_XN2 + (size_t)T * DM * 2 <= WS_A && WS_MIX + (size_t)T * DM * 4 <= WS_XN2, "d_ws map");
static_assert(WS_WIN + (size_t)INW * DM * 2 <= WS_WMKV && WS_WGU + (size_t)NGU * DM * 2 <= WS_WDN && WS_WDN + (size_t)DM * DFF * 2 <= WS_BIAS, "d_ws weight map");

constexpr int LDS_BYTES = 147456;
constexpr int LDS_MISC = 131072 + 1024;
constexpr int CW_BAR = 4096;

__device__ const unsigned char T5B[128] = {0, 1, 2, 3, 4, 5, 6, 7, 8, 9, 10, 11, 12, 13, 14, 15, 16, 16, 16, 17, 17, 18, 18, 18, 19, 19, 19, 20, 20, 20, 20, 21, 21, 21, 21, 22, 22, 22, 22, 22, 23, 23, 23, 23, 23, 23, 24, 24, 24, 24, 24, 24, 25, 25, 25, 25, 25, 25, 25, 26, 26, 26, 26, 26, 26, 26, 26, 27, 27, 27, 27, 27, 27, 27, 27, 27, 27, 28, 28, 28, 28, 28, 28, 28, 28, 28, 28, 29, 29, 29, 29, 29, 29, 29, 29, 29, 29, 29, 29, 30, 30, 30, 30, 30, 30, 30, 30, 30, 30, 30, 30, 30, 30, 31, 31, 31, 31, 31, 31, 31, 31, 31, 31, 31, 31, 31, 31, 31};

#define LAS __attribute__((address_space(3)))
typedef unsigned short bf16;
typedef unsigned v4u __attribute__((ext_vector_type(4)));
typedef unsigned v2u __attribute__((ext_vector_type(2)));
typedef float f32x4 __attribute__((ext_vector_type(4)));
#define LDS_WAIT() asm volatile("s_waitcnt lgkmcnt(0)" ::: "memory")
__device__ __forceinline__ unsigned f2bf(float f) { unsigned u = __builtin_bit_cast(unsigned, f); return (u + 0x7fffu + ((u >> 16) & 1u)) >> 16; }
__device__ __forceinline__ unsigned pk2(float lo, float hi) { return f2bf(lo) | (f2bf(hi) << 16); }
__device__ __forceinline__ float bflo(unsigned u) { return __builtin_bit_cast(float, u << 16); }
__device__ __forceinline__ float bfhi(unsigned u) { return __builtin_bit_cast(float, u & 0xffff0000u); }
__device__ __forceinline__ float bf1(bf16 h) { return __builtin_bit_cast(float, (unsigned)h << 16); }
__device__ __forceinline__ float wave_sum(float v) {
#pragma unroll
    for (int o = 1; o < 64; o <<= 1) v += __shfl_xor(v, o);
    return v;
}
__device__ __forceinline__ float wave_max(float v) {
#pragma unroll
    for (int o = 1; o < 64; o <<= 1) v = fmaxf(v, __shfl_xor(v, o));
    return v;
}
__device__ __forceinline__ float dot8(v4u a, v4u b) {
    float s = bflo(a.x) * bflo(b.x); s += bfhi(a.x) * bfhi(b.x); s += bflo(a.y) * bflo(b.y); s += bfhi(a.y) * bfhi(b.y);
    s += bflo(a.z) * bflo(b.z); s += bfhi(a.z) * bfhi(b.z); s += bflo(a.w) * bflo(b.w); s += bfhi(a.w) * bfhi(b.w); return s;
}
__device__ __forceinline__ float sigmoidf_(float x) { return 1.0f / (1.0f + __expf(-x)); }

struct Frame {
    LAS unsigned char* lds;
    int tid, lane, wave, G, gw, ngw;
    const float *x, *mem, *ln_mix_pre, *ln_mix_post, *w_in, *sinks, *rel_bias, *ln_mem, *w_mem_kv, *w_br0, *w_br1, *w_br2, *w_out, *ln_ffn_pre, *ln_ffn_post, *w_gate, *w_up, *w_down;
    float* out;
    bf16 *WinT, *WmkvT, *WbrT, *WoutT, *WguT, *WdnT, *MN, *MKV, *XN, *MERGED, *PROJ, *XN2, *AH;
    float *BIAS, *MIX;
};

__device__ __forceinline__ void p0_transpose_item(const float* W, int K, int N, bf16* WT, int drow0, int k0, int n0, LAS float* scr, int lane) {
#pragma unroll 8
    for (int i = 0; i < 32; ++i) { const int kk = 2 * i + (lane >> 5); scr[kk * 33 + (lane & 31)] = W[(size_t)(k0 + kk) * N + n0 + (lane & 31)]; }
    LDS_WAIT(); asm volatile("" ::: "memory");
    const int c = lane & 7;
#pragma unroll
    for (int j = 0; j < 4; ++j) { const int n = (lane >> 3) + 8 * j; const LAS float* s = scr + (8 * c) * 33 + n;
        v4u o; o.x = pk2(s[0 * 33], s[1 * 33]); o.y = pk2(s[2 * 33], s[3 * 33]); o.z = pk2(s[4 * 33], s[5 * 33]); o.w = pk2(s[6 * 33], s[7 * 33]);
        *(v4u*)(WT + (size_t)(drow0 + n) * K + k0 + 8 * c) = o; }
    LDS_WAIT(); asm volatile("" ::: "memory");
}
__device__ __forceinline__ void rms_row_to_bf16(const float* xrow, const float* g, bf16* orow, int lane) {
    const f32x4* xr = (const f32x4*)xrow + lane; const f32x4* gr = (const f32x4*)g + lane;
    f32x4 v[4]; float s = 0.f;
#pragma unroll
    for (int j = 0; j < 4; ++j) { v[j] = xr[64 * j]; s += (v[j].x * v[j].x + v[j].y * v[j].y) + (v[j].z * v[j].z + v[j].w * v[j].w); }
    const float rstd = 1.0f / sqrtf(wave_sum(s) * (1.f / DM) + EPS);
    v2u* o8 = (v2u*)orow + lane;
#pragma unroll
    for (int j = 0; j < 4; ++j) { const f32x4 gg = gr[64 * j]; v2u w; w.x = pk2(v[j].x * rstd * gg.x, v[j].y * rstd * gg.y); w.y = pk2(v[j].z * rstd * gg.z, v[j].w * rstd * gg.w); o8[64 * j] = w; }
}

__device__ __forceinline__ void phase_prologue(Frame& F) {
    LAS float* scr = (LAS float*)(F.lds + F.wave * 16384);
    constexpr int I_IN = (DM / 64) * (INW / 32), I_MKV = (DM / 64) * (DM / 32), I_BR = (512 / 64) * (DM / 32), I_OUT = I_MKV, I_G = (DM / 64) * (DFF / 32), I_D = (DFF / 64) * (DM / 32);
    constexpr int NITEMS = I_IN + I_MKV + 3 * I_BR + I_OUT + 2 * I_G + I_D;
    for (int it = F.gw; it < NITEMS; it += F.ngw) {
        int r = it;
        if (r < I_IN) { const int nb = r % (INW / 32), kb = r / (INW / 32); p0_transpose_item(F.w_in, DM, INW, F.WinT, 32 * nb, 64 * kb, 32 * nb, scr, F.lane); continue; } r -= I_IN;
        if (r < I_MKV) { const int nb = r % (DM / 32), kb = r / (DM / 32); p0_transpose_item(F.w_mem_kv, DM, DM, F.WmkvT, 32 * nb, 64 * kb, 32 * nb, scr, F.lane); continue; } r -= I_MKV;
        if (r < I_BR) { const int nb = r % (DM / 32), kb = r / (DM / 32); p0_transpose_item(F.w_br0, 512, DM, F.WbrT, 32 * nb, 64 * kb, 32 * nb, scr, F.lane); continue; } r -= I_BR;
        if (r < I_BR) { const int nb = r % (DM / 32), kb = r / (DM / 32); p0_transpose_item(F.w_br1, 512, DM, F.WbrT + (size_t)DM * 512, 32 * nb, 64 * kb, 32 * nb, scr, F.lane); continue; } r -= I_BR;
        if (r < I_BR) { const int nb = r % (DM / 32), kb = r / (DM / 32); p0_transpose_item(F.w_br2, 512, DM, F.WbrT + (size_t)2 * DM * 512, 32 * nb, 64 * kb, 32 * nb, scr, F.lane); continue; } r -= I_BR;
        if (r < I_OUT) { const int nb = r % (DM / 32), kb = r / (DM / 32); p0_transpose_item(F.w_out, DM, DM, F.WoutT, 32 * nb, 64 * kb, 32 * nb, scr, F.lane); continue; } r -= I_OUT;
        if (r < I_G) { const int nb = r % (DFF / 32), kb = r / (DFF / 32), n0 = 32 * nb;
            p0_transpose_item(F.w_gate, DM, DFF, F.WguT, (n0 / 128) * 256 + (n0 % 128), 64 * kb, n0, scr, F.lane); continue; } r -= I_G;
        if (r < I_G) { const int nb = r % (DFF / 32), kb = r / (DFF / 32), n0 = 32 * nb;
            p0_transpose_item(F.w_up, DM, DFF, F.WguT, (n0 / 128) * 256 + 128 + (n0 % 128), 64 * kb, n0, scr, F.lane); continue; } r -= I_G;
        { const int nb = r % (DM / 32), kb = r / (DM / 32); p0_transpose_item(F.w_down, DFF, DM, F.WdnT, 32 * nb, 64 * kb, 32 * nb, scr, F.lane); }
    }
    for (int m = F.gw; m < T; m += F.ngw) rms_row_to_bf16(F.x + (size_t)m * DM, F.ln_mix_pre, F.XN + (size_t)m * DM, F.lane);
    for (int m = F.gw; m < TM; m += F.ngw) rms_row_to_bf16(F.mem + (size_t)m * DM, F.ln_mem, F.MN + (size_t)m * DM, F.lane);
    for (int i = blockIdx.x * (NWAVES * 64) + F.tid; i < 128 * 8; i += F.G * NWAVES * 64) F.BIAS[i] = F.rel_bias[(int)T5B[i >> 3] * 8 + (i & 7)];
}

struct SchedProj {
    int G, c; const char *XN, *MN, *WinT, *WmkvT;
    __device__ __forceinline__ bool next(int i, pg8::Unit& u) const {
        const int L = i * G + c; constexpr int N1 = (T / 256) * (INW / 256), N2 = (TM / 256) * (DM / 256);
        if (L < N1) { pg8::tile_of(L, T / 256, INW / 256, u.pm, u.pn); u.z = 0; u.a = XN + (size_t)u.pm * 256 * DM * 2; u.b = WinT + (size_t)u.pn * 256 * DM * 2; return true; }
        if (L < N1 + N2) { const int l = L - N1; u.pm = l >> 2; u.pn = l & 3; u.z = 1; u.a = MN + (size_t)u.pm * 256 * DM * 2; u.b = WmkvT + (size_t)u.pn * 256 * DM * 2; return true; }
        return false;
    }
};
struct EpiProj {
    static constexpr bool PERM = true;
    bf16 *PROJ, *MKV;
    __device__ __forceinline__ void operator()(const pg8::f32x4 (&acc)[2][2][4][2], const pg8::Unit& u, int wr, int wc, int fr, int fq) const {
        bf16* base = u.z ? MKV : PROJ; const int ldc = u.z ? DM : INW; const bool sig = (u.z == 0) && (u.pn * 256 >= C_G);
        const int row0 = u.pm * 256 + wr * 64 + fr, col0 = u.pn * 256 + wc * 32 + 8 * fq;
#pragma unroll
        for (int ai = 0; ai < 2; ++ai)
#pragma unroll
            for (int m = 0; m < 4; ++m) { bf16* rowp = base + (size_t)(row0 + ai * 128 + m * 16) * ldc + col0;
#pragma unroll
                for (int bj = 0; bj < 2; ++bj) { pg8::f32x4 v0 = acc[ai][bj][m][0], v1 = acc[ai][bj][m][1];
                    if (sig) {
#pragma unroll
                        for (int e = 0; e < 4; ++e) { v0[e] = sigmoidf_(v0[e]); v1[e] = sigmoidf_(v1[e]); } }
                    pg8::u32x4 w; w.x = pg8::cvt_pk_bf16(v0[0], v0[1]); w.y = pg8::cvt_pk_bf16(v0[2], v0[3]); w.z = pg8::cvt_pk_bf16(v1[0], v1[1]); w.w = pg8::cvt_pk_bf16(v1[2], v1[3]);
                    *(pg8::u32x4*)(rowp + bj * 128) = w; } }
    }
};
struct SchedMerge {
    int G, c; const char *PROJ, *WbrT;
    __device__ __forceinline__ bool next(int i, pg8::Unit& u) const {
        const int ti = i / 3, z = i - 3 * ti, L = ti * G + c;
        if (L >= (T / 256) * (DM / 256)) return false;
        pg8::tile_of(L, T / 256, DM / 256, u.pm, u.pn); u.z = z;
        const int ycol = z == 0 ? C_QA : (z == 1 ? C_QB : C_QM);
        u.a = PROJ + ((size_t)u.pm * 256 * INW + ycol) * 2; u.b = WbrT + ((size_t)z * DM * 512 + (size_t)u.pn * 256 * 512) * 2; return true;
    }
};
struct EpiMerge {
    static constexpr bool PERM = true;
    const bf16* PROJ; bf16* MERGED;
    __device__ __forceinline__ void operator()(const pg8::f32x4 (&acc)[2][2][4][2], const pg8::Unit& u, int wr, int wc, int fr, int fq) const {
        const int row0 = u.pm * 256 + wr * 64 + fr, col0 = u.pn * 256 + wc * 32 + 8 * fq;
#pragma unroll
        for (int ai = 0; ai < 2; ++ai)
#pragma unroll
            for (int m = 0; m < 4; ++m) { const size_t row = (size_t)(row0 + ai * 128 + m * 16);
#pragma unroll
                for (int bj = 0; bj < 2; ++bj) { const int col = col0 + bj * 128;
                    const pg8::u32x4 gq = *(const pg8::u32x4*)(PROJ + row * INW + C_G + u.z * DM + col);
                    pg8::f32x4 v0 = acc[ai][bj][m][0], v1 = acc[ai][bj][m][1];
                    v0[0] *= bflo(gq.x); v0[1] *= bfhi(gq.x); v0[2] *= bflo(gq.y); v0[3] *= bfhi(gq.y); v1[0] *= bflo(gq.z); v1[1] *= bfhi(gq.z); v1[2] *= bflo(gq.w); v1[3] *= bfhi(gq.w);
                    bf16* mp = MERGED + row * DM + col;
                    if (u.z != 0) { const pg8::u32x4 mq = *(const pg8::u32x4*)mp;
                        v0[0] += bflo(mq.x); v0[1] += bfhi(mq.x); v0[2] += bflo(mq.y); v0[3] += bfhi(mq.y); v1[0] += bflo(mq.z); v1[1] += bfhi(mq.z); v1[2] += bflo(mq.w); v1[3] += bfhi(mq.w); }
                    pg8::u32x4 w; w.x = pg8::cvt_pk_bf16(v0[0], v0[1]); w.y = pg8::cvt_pk_bf16(v0[2], v0[3]); w.z = pg8::cvt_pk_bf16(v1[0], v1[1]); w.w = pg8::cvt_pk_bf16(v1[2], v1[3]);
                    *(pg8::u32x4*)mp = w; } }
    }
};
struct SchedPlain {
    int G, c, nM, nN; const char *A, *Bt; size_t astep, bstep;
    __device__ __forceinline__ bool next(int i, pg8::Unit& u) const {
        const int L = i * G + c; if (L >= nM * nN) return false;
        pg8::tile_of(L, nM, nN, u.pm, u.pn); u.z = 0; u.a = A + (size_t)u.pm * astep; u.b = Bt + (size_t)u.pn * bstep; return true;
    }
};
struct EpiF32 {
    static constexpr bool PERM = false;
    float* C; int ldc;
    __device__ __forceinline__ void operator()(const pg8::f32x4 (&acc)[2][2][4][2], const pg8::Unit& u, int wr, int wc, int fr, int fq) const {
        const int row0 = u.pm * 256 + wr * 64 + fr, col0 = u.pn * 256 + wc * 32 + 4 * fq;
#pragma unroll
        for (int ai = 0; ai < 2; ++ai)
#pragma unroll
            for (int m = 0; m < 4; ++m) { float* rowp = C + (size_t)(row0 + ai * 128 + m * 16) * ldc + col0;
#pragma unroll
                for (int bj = 0; bj < 2; ++bj)
#pragma unroll
                    for (int n = 0; n < 2; ++n) *(pg8::f32x4*)(rowp + bj * 128 + n * 16) = acc[ai][bj][m][n]; }
    }
};
struct EpiSwiGLU {
    static constexpr bool PERM = true;
    bf16* AH;
    __device__ __forceinline__ void operator()(const pg8::f32x4 (&acc)[2][2][4][2], const pg8::Unit& u, int wr, int wc, int fr, int fq) const {
        const int row0 = u.pm * 256 + wr * 64 + fr, col0 = u.pn * 128 + wc * 32 + 8 * fq;
#pragma unroll
        for (int ai = 0; ai < 2; ++ai)
#pragma unroll
            for (int m = 0; m < 4; ++m) { bf16* rowp = AH + (size_t)(row0 + ai * 128 + m * 16) * DFF + col0;
                float o[8];
#pragma unroll
                for (int n = 0; n < 2; ++n)
#pragma unroll
                    for (int e = 0; e < 4; ++e) { const float gv = acc[ai][0][m][n][e], uv = acc[ai][1][m][n][e]; o[4 * n + e] = gv * sigmoidf_(gv) * uv; }
                pg8::u32x4 w; w.x = pg8::cvt_pk_bf16(o[0], o[1]); w.y = pg8::cvt_pk_bf16(o[2], o[3]); w.z = pg8::cvt_pk_bf16(o[4], o[5]); w.w = pg8::cvt_pk_bf16(o[6], o[7]);
                *(pg8::u32x4*)rowp = w; }
    }
};

__device__ __forceinline__ void attn_swa_row(Frame& F, int row, int hq) {
    const int lane = F.lane, t = row % SEQ, kvh = hq >> 2;
    const bf16* qp = F.PROJ + (size_t)row * INW + C_QA + hq * 64;
    v4u q[8];
#pragma unroll
    for (int i = 0; i < 8; ++i) q[i] = *(const v4u*)(qp + 8 * i);
    float sc[2]; bool val[2];
#pragma unroll
    for (int j = 0; j < 2; ++j) { const int dist = lane + 64 * j, s = t - dist; val[j] = s >= 0; sc[j] = -INFINITY;
        if (val[j]) { const bf16* kp = F.PROJ + (size_t)(row - dist) * INW + C_KA + kvh * 64; float a = 0.f;
#pragma unroll
            for (int i = 0; i < 8; ++i) a += dot8(q[i], *(const v4u*)(kp + 8 * i));
            sc[j] = a * 0.125f + F.BIAS[dist * 8 + hq]; } }
    const float sink = F.sinks[hq];
    const float mx = fmaxf(wave_max(fmaxf(sc[0], sc[1])), sink);
    float p0 = val[0] ? __expf(sc[0] - mx) : 0.f, p1 = val[1] ? __expf(sc[1] - mx) : 0.f;
    const float den = wave_sum(p0 + p1) + __expf(sink - mx);
    p0 /= den; p1 /= den;
    float y = 0.f; const int nk = t < 127 ? t + 1 : 128;
    const bf16* vp = F.PROJ + (size_t)row * INW + C_VA + kvh * 64 + lane;
    for (int d = 0; d < nk; ++d) { const float w = __shfl(d < 64 ? p0 : p1, d & 63); y += w * bf1(vp[-(ptrdiff_t)d * INW]); }
    ((bf16*)qp)[lane] = (bf16)f2bf(y);
}
__device__ __forceinline__ void attn_sb_row(Frame& F, int row, int h) {
    const int lane = F.lane, t = row % SEQ;
    const bf16* qp = F.PROJ + (size_t)row * INW + C_QB + h * 64;
    v4u q[8];
#pragma unroll
    for (int i = 0; i < 8; ++i) q[i] = *(const v4u*)(qp + 8 * i);
    float carry = 1.f, y = 0.f;
    for (int base = t - 1; base >= 0 && carry != 0.f; base -= 64) {
        const int s = base - lane; const bool valid = s >= 0;
        float beta = 0.f, c = 1.f;
        if (valid) { const bf16* kp = F.PROJ + (size_t)(row - t + s) * INW + C_KB + h * 64; float a = 0.f;
#pragma unroll
            for (int i = 0; i < 8; ++i) a += dot8(q[i], *(const v4u*)(kp + 8 * i));
            const float z = fmaxf(a * 0.125f, -80.f), e = __expf(-z); beta = 1.0f / (1.0f + e); c = e * beta; }
        float incl = c;
#pragma unroll
        for (int o = 1; o < 64; o <<= 1) { const float tq = __shfl_up(incl, o); if (lane >= o) incl *= tq; }
        float excl = __shfl_up(incl, 1); if (lane == 0) excl = 1.f;
        const float a = beta * excl * carry;
        carry *= __shfl(incl, 63);
        const int nv = base + 1 < 64 ? base + 1 : 64;
        const bf16* vp = F.PROJ + (size_t)(row - t + base) * INW + C_VB + h * 64 + lane;
        for (int j = 0; j < nv; ++j) { const float w = __shfl(a, j); y += w * bf1(vp[-(ptrdiff_t)j * INW]); }
    }
    ((bf16*)qp)[lane] = (bf16)f2bf(y);
}
__device__ __forceinline__ void attn_mem_row(Frame& F, int row, int h) {
    const int lane = F.lane, b = row / SEQ;
    const bf16* qp = F.PROJ + (size_t)row * INW + C_QM + h * 128;
    v4u q[16];
#pragma unroll
    for (int i = 0; i < 16; ++i) q[i] = *(const v4u*)(qp + 8 * i);
    float sc[4];
#pragma unroll
    for (int j = 0; j < 4; ++j) { const bf16* kp = F.MKV + (size_t)(b * MEML + lane + 64 * j) * DM + h * 128; float a = 0.f;
#pragma unroll
        for (int i = 0; i < 16; ++i) a += dot8(q[i], *(const v4u*)(kp + 8 * i));
        sc[j] = a * 0.08838834764831845f; }
    const float mx = wave_max(fmaxf(fmaxf(sc[0], sc[1]), fmaxf(sc[2], sc[3])));
    float p[4]; float ps = 0.f;
#pragma unroll
    for (int j = 0; j < 4; ++j) { p[j] = __expf(sc[j] - mx); ps += p[j]; }
    const float den = wave_sum(ps);
    float y0 = 0.f, y1 = 0.f;
    const bf16* vp = F.MKV + (size_t)(b * MEML) * DM + 512 + h * 128 + lane;
#pragma unroll
    for (int j = 0; j < 4; ++j)
        for (int m = 0; m < 64; ++m) { const float w = __shfl(p[j], m); const bf16* v = vp + (size_t)(64 * j + m) * DM; y0 += w * bf1(v[0]); y1 += w * bf1(v[64]); }
    ((bf16*)qp)[lane] = (bf16)f2bf(y0 / den); ((bf16*)qp)[lane + 64] = (bf16)f2bf(y1 / den);
}
#ifndef ATTN_MFMA_SB
#define ATTN_MFMA_SB 1
#endif
#ifndef ATTN_MFMA_SWA
#define ATTN_MFMA_SWA 1
#endif
#ifndef ATTN_MFMA_MEM
#define ATTN_MFMA_MEM 1
#endif
namespace at {
typedef short bf16x8 __attribute__((ext_vector_type(8)));
typedef float f32x16 __attribute__((ext_vector_type(16)));
typedef short s16x4 __attribute__((ext_vector_type(4)));
typedef float f32x2_t __attribute__((ext_vector_type(2)));
typedef __bf16 bf16x2_t __attribute__((ext_vector_type(2)));
constexpr float LOG2E = 1.4426950408889634f;
constexpr int LDS_V = 0, LDS_SC = 65536, LDS_TB = 65536 + 8 * 256, TB_N = 192;
__device__ __forceinline__ unsigned cvtpk(float lo, float hi) { f32x2_t v = {lo, hi}; bf16x2_t b = __builtin_convertvector(v, bf16x2_t); return __builtin_bit_cast(unsigned, b); }
__device__ __forceinline__ int kperm(int r) { return 16 * ((r >> 2) & 1) + 4 * (r >> 3) + (r & 3); }
__device__ __forceinline__ int crow(int i, int h) { return (i & 3) + 8 * (i >> 2) + 4 * h; }
__device__ __forceinline__ float xhalf(float v) { return __shfl_xor(v, 32); }
#define AT_MFMA(a, b, c) __builtin_amdgcn_mfma_f32_32x32x16_bf16((a), (b), (c), 0, 0, 0)

template <int D> __device__ __forceinline__ void load_q(bf16x8 (&qf)[D / 16], const bf16* Q, size_t pitch, int q0, int lane) {
    const bf16* p = Q + (size_t)(q0 + (lane & 31)) * pitch + 8 * (lane >> 5);
#pragma unroll
    for (int s = 0; s < D / 16; ++s) qf[s] = *(const bf16x8*)(p + 16 * s);
}
template <int D> __device__ __forceinline__ void load_k(bf16x8 (&kf)[D / 16], const bf16* K, size_t pitch, int k0, int lane) {
    const bf16* p = K + (size_t)(k0 + kperm(lane & 31)) * pitch + 8 * (lane >> 5);
#pragma unroll
    for (int s = 0; s < D / 16; ++s) kf[s] = *(const bf16x8*)(p + 16 * s);
}
template <int D> __device__ __forceinline__ f32x16 qk(const bf16x8 (&kf)[D / 16], const bf16x8 (&qf)[D / 16]) {
    f32x16 acc;
#pragma unroll
    for (int i = 0; i < 16; ++i) acc[i] = 0.f;
#pragma unroll
    for (int s = 0; s < D / 16; ++s) acc = AT_MFMA(kf[s], qf[s], acc);
    return acc;
}
template <int D> __device__ __forceinline__ void load_v(v4u (&vr)[D / 16], const bf16* V, size_t pitch, int k0, int lane) {
#pragma unroll
    for (int w = 0; w < D / 16; ++w) { const int ci = lane + 64 * w, kk = ci / (D / 8), c = ci % (D / 8); vr[w] = *(const v4u*)(V + (size_t)(k0 + kk) * pitch + 8 * c); }
}
template <int D> __device__ __forceinline__ int vswz(int kk) { return D == 64 ? (((kk >> 1) & 1) << 2) : ((kk & 3) << 2); }
template <int D> __device__ __forceinline__ void store_v(const v4u (&vr)[D / 16], LAS unsigned char* vl, int lane) {
#pragma unroll
    for (int w = 0; w < D / 16; ++w) { const int ci = lane + 64 * w, kk = ci / (D / 8), c = ci % (D / 8); *(LAS v4u*)(vl + kk * (D * 2) + ((c ^ vswz<D>(kk)) << 4)) = vr[w]; }
}
__device__ __forceinline__ s16x4 vtr(LAS unsigned char* p) { typedef short v4i16_t __attribute__((ext_vector_type(4))); return __builtin_bit_cast(s16x4, __builtin_amdgcn_ds_read_tr16_b64_v4i16((LAS v4i16_t*)p)); }
template <int D> __device__ __forceinline__ void pv(f32x16 (&o)[D / 32], const bf16x8 (&pa)[2], LAS unsigned char* vl, int lane) {
    const int g = lane >> 4, q = (lane & 15) >> 2, p = lane & 3, h = g >> 1;
#pragma unroll
    for (int db = 0; db < D / 32; ++db)
#pragma unroll
        for (int s = 0; s < 2; ++s) {
            s16x4 t[2];
#pragma unroll
            for (int u = 0; u < 2; ++u) { const int kk = 16 * h + 8 * s + 4 * u + q, chunk = db * 4 + 2 * (g & 1) + (p >> 1);
                t[u] = vtr(vl + kk * (D * 2) + ((chunk ^ vswz<D>(kk)) << 4) + (p & 1) * 8); }
            const bf16x8 vf = (bf16x8){t[0][0], t[0][1], t[0][2], t[0][3], t[1][0], t[1][1], t[1][2], t[1][3]};
            o[db] = AT_MFMA(pa[s], vf, o[db]);
        }
}
__device__ __forceinline__ void pack_p(bf16x8 (&pa)[2], const float (&a)[16]) {
#pragma unroll
    for (int s = 0; s < 2; ++s) { v4u w; w.x = cvtpk(a[8 * s], a[8 * s + 1]); w.y = cvtpk(a[8 * s + 2], a[8 * s + 3]); w.z = cvtpk(a[8 * s + 4], a[8 * s + 5]); w.w = cvtpk(a[8 * s + 6], a[8 * s + 7]); pa[s] = __builtin_bit_cast(bf16x8, w); }
}
template <int D> __device__ __forceinline__ void store_o(const f32x16 (&o)[D / 32], bf16* Y, size_t pitch, int q0, int lane, const LAS float* sc) {
    const int d = lane & 31, hh = lane >> 5;
#pragma unroll
    for (int i = 0; i < 16; ++i) { const int qr = crow(i, hh); const float f = sc ? sc[qr] : 1.f; bf16* yp = Y + (size_t)(q0 + qr) * pitch + d;
#pragma unroll
        for (int db = 0; db < D / 32; ++db) yp[db * 32] = (bf16)f2bf(o[db][i] * f); }
}

__device__ __forceinline__ void sb_block(const bf16* Qh, const bf16* Kh, const bf16* Vh, bf16* Yh, int q0, LAS unsigned char* vl, int lane) {
    constexpr int D = 64; constexpr float C1 = 0.125f * LOG2E;
    const int n = lane & 31, h = lane >> 5;
    bf16x8 qf[4]; load_q<D>(qf, Qh, INW, q0, lane);
    f32x16 o[2];
#pragma unroll
    for (int i = 0; i < 16; ++i) { o[0][i] = 0.f; o[1][i] = 0.f; }
    float carry = 1.f;
    bf16x8 kf[4]; v4u vr[4];
    load_k<D>(kf, Kh, INW, q0, lane); load_v<D>(vr, Vh, INW, q0, lane);
    for (int k0 = q0; k0 >= 0; k0 -= 32) {
        const f32x16 S = qk<D>(kf, qf);
        store_v<D>(vr, vl, lane);
        if (k0 >= 32) { load_k<D>(kf, Kh, INW, k0 - 32, lane); load_v<D>(vr, Vh, INW, k0 - 32, lane); }
        const bool diag = (k0 == q0);
        float bp[16]; float P = 1.f;
#pragma unroll
        for (int i = 15; i >= 0; --i) {
            const float z = fmaxf(S[i] * C1, -100.f), e = __builtin_amdgcn_exp2f(-z);
            float b = __builtin_amdgcn_rcpf(1.0f + e), c = e * b;
            if (diag && (16 * h + i >= n)) { b = 0.f; c = 1.f; }
            bp[i] = b * P; P *= c;
        }
        const float To = xhalf(P);
        const float cl = h ? carry : carry * To;
        float a[16];
#pragma unroll
        for (int i = 0; i < 16; ++i) a[i] = bp[i] * cl;
        carry = carry * P * To;
        bf16x8 pa[2]; pack_p(pa, a);
        pv<D>(o, pa, vl, lane);
        if (__ballot(carry != 0.f) == 0ull) break;
    }
    store_o<D>(o, Yh, INW, q0, lane, nullptr);
}

__device__ __forceinline__ void swa_block(const bf16* Qh, const bf16* Kh, const bf16* Vh, bf16* Yh, int q0, float sink2, const LAS float* tb  , LAS unsigned char* vl, LAS float* sc, int lane) {
    constexpr int D = 64; constexpr float C1 = 0.125f * LOG2E;
    const int n = lane & 31, h = lane >> 5;
    bf16x8 qf[4]; load_q<D>(qf, Qh, INW, q0, lane);
    const int klo = q0 >= 128 ? q0 - 128 : 0;
    bf16x8 kf[4];
    float m = sink2;
    for (int k0 = klo; k0 <= q0; k0 += 32) {
        load_k<D>(kf, Kh, INW, k0, lane);
        const f32x16 S = qk<D>(kf, qf);
        const int dl = q0 - k0; const LAS float* tp = tb + (dl + n - 16 * h + 32 - 15);
#pragma unroll
        for (int i = 0; i < 16; ++i) { const int dist = dl + n - 16 * h - i; const float sv = S[i] * C1 + tp[15 - i]; if (dist >= 0 && dist < 128) m = fmaxf(m, sv); }
    }
    m = fmaxf(m, xhalf(m));
    f32x16 o[2];
#pragma unroll
    for (int i = 0; i < 16; ++i) { o[0][i] = 0.f; o[1][i] = 0.f; }
    float l = 0.f; v4u vr[4];
    for (int k0 = klo; k0 <= q0; k0 += 32) {
        load_k<D>(kf, Kh, INW, k0, lane); load_v<D>(vr, Vh, INW, k0, lane);
        const f32x16 S = qk<D>(kf, qf);
        store_v<D>(vr, vl, lane);
        const int dl = q0 - k0; const LAS float* tp = tb + (dl + n - 16 * h + 32 - 15);
        float a[16];
#pragma unroll
        for (int i = 0; i < 16; ++i) { const int dist = dl + n - 16 * h - i; const float sv = S[i] * C1 + tp[15 - i]; a[i] = (dist >= 0 && dist < 128) ? __builtin_amdgcn_exp2f(sv - m) : 0.f; l += a[i]; }
        bf16x8 pa[2]; pack_p(pa, a);
        pv<D>(o, pa, vl, lane);
    }
    l += xhalf(l); l += __builtin_amdgcn_exp2f(sink2 - m);
    if (h == 0) sc[n] = 1.0f / l;
    LDS_WAIT();
    store_o<D>(o, Yh, INW, q0, lane, sc);
    LDS_WAIT();
}

__device__ __forceinline__ void mem_block(const bf16* Qh, const bf16* Kh, const bf16* Vh, bf16* Yh, int q0, LAS unsigned char* vl, LAS float* sc, int lane) {
    constexpr int D = 128; constexpr float C1 = 0.08838834764831845f * LOG2E;
    const int n = lane & 31, h = lane >> 5;
    bf16x8 qf[8]; load_q<D>(qf, Qh, INW, q0, lane);
    bf16x8 kf[8];
    float m = -INFINITY;
    for (int k0 = 0; k0 < MEML; k0 += 32) {
        load_k<D>(kf, Kh, DM, k0, lane);
        const f32x16 S = qk<D>(kf, qf);
#pragma unroll
        for (int i = 0; i < 16; ++i) m = fmaxf(m, S[i]);
    }
    m = fmaxf(m, xhalf(m)) * C1;
    f32x16 o[4];
#pragma unroll
    for (int i = 0; i < 16; ++i) { o[0][i] = 0.f; o[1][i] = 0.f; o[2][i] = 0.f; o[3][i] = 0.f; }
    float l = 0.f; v4u vr[8];
    for (int k0 = 0; k0 < MEML; k0 += 32) {
        load_k<D>(kf, Kh, DM, k0, lane); load_v<D>(vr, Vh, DM, k0, lane);
        const f32x16 S = qk<D>(kf, qf);
        store_v<D>(vr, vl, lane);
        float a[16];
#pragma unroll
        for (int i = 0; i < 16; ++i) { a[i] = __builtin_amdgcn_exp2f(S[i] * C1 - m); l += a[i]; }
        bf16x8 pa[2]; pack_p(pa, a);
        pv<D>(o, pa, vl, lane);
    }
    l += xhalf(l);
    if (h == 0) sc[n] = 1.0f / l;
    LDS_WAIT();
    store_o<D>(o, Yh, INW, q0, lane, sc);
    LDS_WAIT();
    (void)n;
}
}

__device__ __forceinline__ void phase_attention(Frame& F) {
    const int c = (int)blockIdx.x, lane = F.lane;
    const int myid = ((((c >> 3) * NWAVES) + F.wave) << 3) | (c & 7);
    LAS unsigned char* vl = F.lds + at::LDS_V + F.wave * 8192;
    LAS float* sc = (LAS float*)(F.lds + at::LDS_SC) + F.wave * 64;
    LAS float* tb = (LAS float*)(F.lds + at::LDS_TB);
    for (int i = F.tid; i < 8 * at::TB_N; i += NWAVES * 64) { const int hq = i / at::TB_N, dist = i % at::TB_N - 32; tb[i] = (dist >= 0 && dist < 128) ? F.BIAS[dist * 8 + hq] * at::LOG2E : 0.f; }
    __syncthreads();
#if ATTN_MFMA_SB
    for (int t = myid; t < 128 * 32; t += F.ngw) {
        const int x = t & 7, rest = t >> 3, pp = rest >> 5, j = rest & 31, pair = x + 8 * pp, b = pair >> 3, h = pair & 7;
        const bf16* base = F.PROJ + (size_t)b * SEQ * INW + h * 64;
        at::sb_block(base + C_QB, base + C_KB, base + C_VB, (bf16*)base + C_QB, 32 * (63 - j), vl, lane);
        at::sb_block(base + C_QB, base + C_KB, base + C_VB, (bf16*)base + C_QB, 32 * j, vl, lane);
    }
#else
    for (int it = F.gw; it < T * 8; it += F.ngw) attn_sb_row(F, it >> 3, it & 7);
#endif
#if ATTN_MFMA_MEM
    for (int t = myid; t < 64 * 64; t += F.ngw) {
        const int x = t & 7, rest = t >> 3, pp = rest >> 6, qb = rest & 63, pair = x + 8 * pp, b = pair >> 2, h = pair & 3;
        const bf16* qbase = F.PROJ + (size_t)b * SEQ * INW + C_QM + h * 128; const bf16* kbase = F.MKV + (size_t)b * MEML * DM + h * 128;
        at::mem_block(qbase, kbase, kbase + 512, (bf16*)qbase, 32 * qb, vl, sc, lane);
    }
#else
    for (int it = F.gw; it < T * 4; it += F.ngw) attn_mem_row(F, it >> 2, it & 3);
#endif
#if ATTN_MFMA_SWA
    for (int t = myid; t < 32 * 256; t += F.ngw) {
        const int x = t & 7, rest = t >> 3, pi = rest >> 8, w = rest & 255, g = w >> 6, qb = w & 63, pair = x + 8 * pi, b = pair >> 1, kvh = pair & 1, hq = kvh * 4 + g;
        const bf16* base = F.PROJ + (size_t)b * SEQ * INW;
        at::swa_block(base + C_QA + hq * 64, base + C_KA + kvh * 64, base + C_VA + kvh * 64, (bf16*)base + C_QA + hq * 64, 32 * qb, F.sinks[hq] * at::LOG2E, tb + hq * at::TB_N, vl, sc, lane);
    }
#else
    for (int it = F.gw; it < T * 8; it += F.ngw) attn_swa_row(F, it >> 3, it & 7);
#endif
}

__device__ __forceinline__ void phase_norm1(Frame& F) {
    for (int m = F.gw; m < T; m += F.ngw) {
        const f32x4* mr = (const f32x4*)(F.MIX + (size_t)m * DM) + F.lane; const f32x4* xr = (const f32x4*)(F.x + (size_t)m * DM) + F.lane;
        const f32x4* g1 = (const f32x4*)F.ln_mix_post + F.lane; const f32x4* g2 = (const f32x4*)F.ln_ffn_pre + F.lane;
        f32x4 v[4]; float s = 0.f;
#pragma unroll
        for (int j = 0; j < 4; ++j) { v[j] = mr[64 * j]; s += (v[j].x * v[j].x + v[j].y * v[j].y) + (v[j].z * v[j].z + v[j].w * v[j].w); }
        const float rstd = 1.0f / sqrtf(wave_sum(s) * (1.f / DM) + EPS);
        float s2 = 0.f; f32x4* orow = (f32x4*)(F.out + (size_t)m * DM) + F.lane;
#pragma unroll
        for (int j = 0; j < 4; ++j) { v[j] = xr[64 * j] + v[j] * rstd * g1[64 * j]; orow[64 * j] = v[j]; s2 += (v[j].x * v[j].x + v[j].y * v[j].y) + (v[j].z * v[j].z + v[j].w * v[j].w); }
        const float rstd2 = 1.0f / sqrtf(wave_sum(s2) * (1.f / DM) + EPS);
        v2u* o8 = (v2u*)(F.XN2 + (size_t)m * DM) + F.lane;
#pragma unroll
        for (int j = 0; j < 4; ++j) { const f32x4 gg = g2[64 * j]; v2u w; w.x = pk2(v[j].x * rstd2 * gg.x, v[j].y * rstd2 * gg.y); w.y = pk2(v[j].z * rstd2 * gg.z, v[j].w * rstd2 * gg.w); o8[64 * j] = w; }
    }
}
__device__ __forceinline__ void phase_norm2(Frame& F) {
    for (int m = F.gw; m < T; m += F.ngw) {
        const f32x4* fr = (const f32x4*)(F.MIX + (size_t)m * DM) + F.lane; f32x4* orow = (f32x4*)(F.out + (size_t)m * DM) + F.lane;
        const f32x4* g1 = (const f32x4*)F.ln_ffn_post + F.lane;
        f32x4 v[4]; float s = 0.f;
#pragma unroll
        for (int j = 0; j < 4; ++j) { v[j] = fr[64 * j]; s += (v[j].x * v[j].x + v[j].y * v[j].y) + (v[j].z * v[j].z + v[j].w * v[j].w); }
        const float rstd = 1.0f / sqrtf(wave_sum(s) * (1.f / DM) + EPS);
#pragma unroll
        for (int j = 0; j < 4; ++j) orow[64 * j] = orow[64 * j] + v[j] * rstd * g1[64 * j];
    }
}

#define XB_TMO      128
#define XB_XCNT(j)  (256  + 64 * (j))
#define XB_XSUB(j)  (1280 + 64 * (j))
#define XB_XGEN(j)  (2304 + 64 * (j))
#define XB_TOP      3328
#define XB_TOPGEN   3392
#define XCD_BAR_WORDS 3456
#define XB_SPIN_CAP (1u << 18)
__device__ __forceinline__ unsigned xb_ld(unsigned* p)              { return __hip_atomic_load(p, __ATOMIC_RELAXED, __HIP_MEMORY_SCOPE_AGENT); }
__device__ __forceinline__ unsigned xb_add(unsigned* p, unsigned v) { return __hip_atomic_fetch_add(p, v, __ATOMIC_RELAXED, __HIP_MEMORY_SCOPE_AGENT); }
__device__ __forceinline__ unsigned xb_xcc_id() { return (unsigned)__builtin_amdgcn_s_getreg((3 << 11) | 20) & 0xFu; }
#define XB_SPIN(cond, bar) do { unsigned _sp = 0; while (cond) { __builtin_amdgcn_s_sleep(1); \
    if ((++_sp & 255u) == 0u) { if (xb_ld(&(bar)[XB_TMO])) break; if (_sp > XB_SPIN_CAP) { atomicAdd(&(bar)[XB_TMO], 1u); break; } } } } while (0)
struct XcdBarrier { unsigned* bar; unsigned x; volatile LAS unsigned* st; };
__device__ __forceinline__ XcdBarrier xcd_barrier_post(unsigned* bar, volatile LAS unsigned* st) {
    XcdBarrier b; b.bar = bar; b.x = xb_xcc_id(); b.st = st;
    if (threadIdx.x == 0) (void)xb_add(&bar[XB_XCNT(b.x)], 1u);
    return b;
}
__device__ __forceinline__ void xcd_barrier_complete(unsigned* bar, unsigned x, unsigned& nloc, unsigned& nx) {
    const unsigned G = gridDim.x * gridDim.y * gridDim.z;
    unsigned sum, cnt, mine, sp = 0u;
    for (;;) {
        sum = 0u; cnt = 0u; mine = 0u;
#pragma unroll
        for (unsigned j = 0; j < 16; ++j) { const unsigned c = xb_ld(&bar[XB_XCNT(j)]); sum += c; cnt += (c > 0u) ? 1u : 0u; mine = (j == x) ? c : mine; }
        if (sum == G) break;
        __builtin_amdgcn_s_sleep(1);
        if ((++sp & 255u) == 0u) { if (xb_ld(&bar[XB_TMO])) break; if (sp > XB_SPIN_CAP) { atomicAdd(&bar[XB_TMO], 1u); break; } }
    }
    nloc = mine > 0u ? mine : 1u; nx = cnt > 0u ? cnt : 1u;
}
__device__ __forceinline__ void xcd_barrier(const XcdBarrier& b) {
    asm volatile("s_waitcnt vmcnt(0)" ::: "memory");
    __syncthreads();
    if (threadIdx.x == 0) {
        unsigned* bar = b.bar;
        __builtin_amdgcn_s_waitcnt(0);
        unsigned nloc = b.st[0], nx = b.st[1];
        if (nloc == 0u) { xcd_barrier_complete(bar, b.x, nloc, nx); b.st[0] = nloc; b.st[1] = nx; }
        const unsigned old = xb_add(&bar[XB_XSUB(b.x)], 1u);
        const unsigned gen = old / nloc;
        if (old + 1u == (gen + 1u) * nloc) {
            __builtin_amdgcn_fence(__ATOMIC_RELEASE, "agent");
            asm volatile("s_waitcnt vmcnt(0)" ::: "memory");
            const unsigned og = xb_add(&bar[XB_TOP], 1u);
            const unsigned tg = og / nx;
            if (og + 1u == (tg + 1u) * nx) xb_add(&bar[XB_TOPGEN], 1u);
            else XB_SPIN(xb_ld(&bar[XB_TOPGEN]) == tg, bar);
            __builtin_amdgcn_fence(__ATOMIC_ACQUIRE, "agent");
            xb_add(&bar[XB_XGEN(b.x)], 1u);
            asm volatile("s_waitcnt vmcnt(0)" ::: "memory");
        } else {
            XB_SPIN(xb_ld(&bar[XB_XGEN(b.x)]) == gen, bar);
            __builtin_amdgcn_fence(__ATOMIC_ACQUIRE, "agent");
            asm volatile("s_waitcnt vmcnt(0)" ::: "memory");
        }
    }
    __syncthreads();
}

struct Args { const float* in[18]; float* out; unsigned char* ws; int ph_lo, ph_hi, coop_probe, pad; };
__global__ void __launch_bounds__(NWAVES * 64, 2) mk_fwd(Args args) {
    extern __shared__ __attribute__((aligned(16))) unsigned char lds[];
    Frame F;
    F.lds = (LAS unsigned char*)lds;
    F.tid = threadIdx.x; F.lane = F.tid & 63; F.wave = __builtin_amdgcn_readfirstlane(F.tid >> 6);
    F.G = gridDim.x; F.gw = blockIdx.x * NWAVES + F.wave; F.ngw = F.G * NWAVES;
    unsigned char* ws = args.ws;
    F.x = args.in[0]; F.mem = args.in[1]; F.ln_mix_pre = args.in[2]; F.ln_mix_post = args.in[3]; F.w_in = args.in[4]; F.sinks = args.in[5]; F.rel_bias = args.in[6]; F.ln_mem = args.in[7];
    F.w_mem_kv = args.in[8]; F.w_br0 = args.in[9]; F.w_br1 = args.in[10]; F.w_br2 = args.in[11]; F.w_out = args.in[12]; F.ln_ffn_pre = args.in[13]; F.ln_ffn_post = args.in[14];
    F.w_gate = args.in[15]; F.w_up = args.in[16]; F.w_down = args.in[17]; F.out = args.out;
    F.WinT = (bf16*)(ws + WS_WIN); F.WmkvT = (bf16*)(ws + WS_WMKV); F.WbrT = (bf16*)(ws + WS_WBR); F.WoutT = (bf16*)(ws + WS_WOUT); F.WguT = (bf16*)(ws + WS_WGU); F.WdnT = (bf16*)(ws + WS_WDN);
    F.BIAS = (float*)(ws + WS_BIAS); F.MN = (bf16*)(ws + WS_MN); F.MKV = (bf16*)(ws + WS_MKV); F.XN = (bf16*)(ws + WS_XN); F.MERGED = (bf16*)(ws + WS_XN); F.PROJ = (bf16*)(ws + WS_PROJ);
    F.MIX = (float*)(ws + WS_MIX); F.XN2 = (bf16*)(ws + WS_XN2); F.AH = (bf16*)(ws + WS_A);
    const int lo = args.ph_lo, hi = args.ph_hi;
    volatile LAS unsigned* MISC = (volatile LAS unsigned*)(F.lds + LDS_MISC);
    if (F.tid < 16) MISC[F.tid] = 0u;
    __syncthreads();
    XcdBarrier bar = xcd_barrier_post((unsigned*)(ws + WS_CTL) + CW_BAR, MISC + 8);
    if (args.coop_probe) cg::this_grid().sync();
#define IN(k) (lo <= (k) && (k) < hi)
#define SEAM(k) do { if (IN(k) && IN((k) + 1)) { xcd_barrier(bar); } } while (0)
    const int c = (int)blockIdx.x;

    if (IN(0)) { phase_prologue(F); }
    SEAM(0);
    if (IN(1)) {
        pg8::Gemm g{DM, DM, DM}; SchedProj S{F.G, c, (const char*)F.XN, (const char*)F.MN, (const char*)F.WinT, (const char*)F.WmkvT}; EpiProj E{F.PROJ, F.MKV};
        pg8::gemm_phase<EpiProj, SchedProj, true, true>(F.lds, g, S, E);
    }
    SEAM(1);
    if (IN(2)) { phase_attention(F); }
    SEAM(2);
    if (IN(3)) {
        pg8::Gemm g{INW, 512, 512}; SchedMerge S{F.G, c, (const char*)F.PROJ, (const char*)F.WbrT}; EpiMerge E{F.PROJ, F.MERGED};
        pg8::gemm_phase<EpiMerge, SchedMerge, true, true>(F.lds, g, S, E);
    }
    SEAM(3);
    if (IN(4)) {
        pg8::Gemm g{DM, DM, DM}; SchedPlain S{F.G, c, T / 256, DM / 256, (const char*)F.MERGED, (const char*)F.WoutT, (size_t)256 * DM * 2, (size_t)256 * DM * 2}; EpiF32 E{F.MIX, DM};
        pg8::gemm_phase<EpiF32, SchedPlain, true, true>(F.lds, g, S, E);
    }
    SEAM(4);
    if (IN(5)) { phase_norm1(F); }
    SEAM(5);
    if (IN(6)) {
        pg8::Gemm g{DM, DM, DM}; SchedPlain S{F.G, c, T / 256, NGU / 256, (const char*)F.XN2, (const char*)F.WguT, (size_t)256 * DM * 2, (size_t)256 * DM * 2}; EpiSwiGLU E{F.AH};
        pg8::gemm_phase<EpiSwiGLU, SchedPlain, true, true>(F.lds, g, S, E);
    }
    SEAM(6);
    if (IN(7)) {
        pg8::Gemm g{DFF, DFF, DFF}; SchedPlain S{F.G, c, T / 256, DM / 256, (const char*)F.AH, (const char*)F.WdnT, (size_t)256 * DFF * 2, (size_t)256 * DFF * 2}; EpiF32 E{F.MIX, DM};
        pg8::gemm_phase<EpiF32, SchedPlain, true, true>(F.lds, g, S, E);
    }
    SEAM(7);
    if (IN(8)) { phase_norm2(F); }
#undef IN
#undef SEAM
}

extern "C" void kernel_launch(void* const* d_in, const int* in_sizes, int n_in, void* d_out, int out_size, void* d_ws, size_t ws_size, hipStream_t stream) {
    static int grid = 0;
    if (grid == 0) {
        if (n_in != 18 || in_sizes[0] != T * DM || out_size != T * DM || ws_size < WS_END) { fprintf(stderr, "kernel_launch: unexpected shapes: n_in %d in0 %d out %d ws %zu (need %zu)\n", n_in, n_in > 0 ? in_sizes[0] : -1, out_size, ws_size, (size_t)WS_END); grid = -1; return; }
        int dev = 0, cus = 0, per_cu = 0;
        if (hipGetDevice(&dev) != hipSuccess || hipDeviceGetAttribute(&cus, hipDeviceAttributeMultiprocessorCount, dev) != hipSuccess) { grid = -1; return; }
        if (hipFuncSetAttribute((const void*)mk_fwd, hipFuncAttributeMaxDynamicSharedMemorySize, LDS_BYTES) != hipSuccess) { fprintf(stderr, "kernel_launch: hipFuncSetAttribute failed\n"); grid = -1; return; }
        if (hipOccupancyMaxActiveBlocksPerMultiprocessor(&per_cu, (const void*)mk_fwd, NWAVES * 64, LDS_BYTES) != hipSuccess || per_cu < 1) { fprintf(stderr, "kernel_launch: occupancy query says %d\n", per_cu); per_cu = 1; }
        (void)hipGetLastError();
        grid = cus;
    }
    if (grid < 0) return;
    if (hipMemsetAsync((char*)d_ws + WS_CTL, 0, CTL_ZERO_BYTES, stream) != hipSuccess) { fprintf(stderr, "kernel_launch: hipMemsetAsync failed\n"); return; }
    Args a{};
    for (int i = 0; i < 18; ++i) a.in[i] = (const float*)d_in[i];
    a.out = (float*)d_out; a.ws = (unsigned char*)d_ws;
#if MK_N_LAUNCHES == 1
    a.ph_lo = 0; a.ph_hi = N_PHASES;
    void* kargs[] = {&a};
    hipError_t e = hipLaunchCooperativeKernel((const void*)mk_fwd, dim3(grid), dim3(NWAVES * 64), kargs, LDS_BYTES, stream);
    if (e != hipSuccess) fprintf(stderr, "kernel_launch: cooperative launch failed: %s (grid %d)\n", hipGetErrorString(e), grid);
#else
    for (int p = 0; p < N_PHASES; ++p) {
        a.ph_lo = p; a.ph_hi = p + 1;
        hipLaunchKernelGGL(mk_fwd, dim3(grid), dim3(NWAVES * 64), LDS_BYTES, stream, a);
    }
#endif
}
```

```cpp
#include <hip/hip_runtime.h>
#include <hip/hip_cooperative_groups.h>
#include <cstdio>
#include <cstdint>
namespace cg = cooperative_groups;

#ifndef MK_N_LAUNCHES
#define MK_N_LAUNCHES 1
#endif

namespace pg8 {
#define PG8_LAS __attribute__((address_space(3)))
typedef unsigned short bf16_t;
typedef short bf16x8 __attribute__((ext_vector_type(8)));
typedef float f32x4 __attribute__((ext_vector_type(4)));
typedef unsigned u32x4 __attribute__((ext_vector_type(4)));
constexpr int BM = 256, BK = 64, HALF = 128, HTB = HALF * BK * 2  , STAGE_BYTES = 8 * HTB, NXCD = 8, WGM = 8;

__host__ __device__ __forceinline__ int lds_byte(int r, int c) { const int st = (r >> 4) * 2 + (c >> 5), rr = r & 15, cc = c & 31, ob = rr * 64 + cc * 2; return st * 1024 + (ob ^ (((ob >> 9) & 1) << 5)); }
__host__ __device__ __forceinline__ void stage_rc(int b, int& R, int& C) { const int st = b / 1024, sb = b % 1024, swz = sb ^ (((sb >> 9) & 1) << 5); R = (st >> 1) * 16 + swz / 64; C = (st & 1) * 32 + (swz % 64) / 2; }
__host__ __device__ __forceinline__ int perm32(int rho) { const int n = rho >> 4, i = rho & 15; return 8 * (i >> 2) + 4 * n + (i & 3); }

struct Unit { int pm, pn, z; const char* a; const char* b; };
struct Gemm { int lda, ldb, K; };

__device__ __forceinline__ void tile_of(int L, int nM, int nN, int& pm, int& pn) {
    const int nwg = nM * nN; int wgid = L;
    { const int q = nwg / NXCD, r = nwg % NXCD, xcd = wgid % NXCD, off = wgid / NXCD; wgid = (xcd < r ? xcd * (q + 1) : r * (q + 1) + (xcd - r) * q) + off; }
    const int nig = WGM * nN, gid = wgid / nig, fm = gid * WGM, gsz = (nM - fm) < WGM ? (nM - fm) : WGM;
    pm = fm + ((wgid % nig) % gsz); pn = (wgid % nig) / gsz;
}

__device__ __forceinline__ unsigned cvt_pk_bf16(float lo, float hi) { unsigned r; asm volatile("v_cvt_pk_bf16_f32 %0, %1, %2" : "=v"(r) : "v"(lo), "v"(hi)); return r; }

template <class Epi, class Sched, bool ALIGN_EPI = false, bool SP2 = false>
__device__ __forceinline__ void gemm_phase(PG8_LAS unsigned char* lds, const Gemm g, const Sched& S, const Epi& E) {
    const int tid = threadIdx.x, wid = __builtin_amdgcn_readfirstlane(tid >> 6), lane = tid & 63, wr = wid >> 2, wc = wid & 3, fr = lane & 15, fq = lane >> 4;
    const int K = g.K, nt = K / BK;
    unsigned voffA[2], voffB[2];
#pragma unroll
    for (int i = 0; i < 2; ++i) { int R, C; stage_rc(tid * 16 + i * 8192, R, C); const int Rb = Epi::PERM ? ((R & ~31) + perm32(R & 31)) : R;
        voffA[i] = (unsigned)(R * g.lda + C) * 2u; voffB[i] = (unsigned)(Rb * g.ldb + C) * 2u; }
    const size_t kstep = (size_t)(BK * 2);
    const size_t hstepA = (size_t)HALF * g.lda * 2, hstepB = (size_t)HALF * g.ldb * 2;
    const unsigned ldsw = (unsigned)wid * 1024u;
    const int aoff = lds_byte(wr * 64 + fr, fq * 8), boff = lds_byte(wc * 32 + fr, fq * 8);
#define PG8_SA(b, h) (((b) * 2 + (h)) * HTB)
#define PG8_SB(b, h) ((4 + (b) * 2 + (h)) * HTB)
#define PG8_STAGE(bufoff, gbase, voff) do { _Pragma("unroll") for (int _i = 0; _i < 2; ++_i) \
        __builtin_amdgcn_global_load_lds((const unsigned*)((const char*)(gbase) + (voff)[_i]), (PG8_LAS unsigned*)(lds + (bufoff) + ldsw + _i * 8192), 16, 0, 0); } while (0)
#define PG8_LDA(dst, b, h) do { _Pragma("unroll") for (int m = 0; m < 4; ++m) _Pragma("unroll") for (int k = 0; k < 2; ++k) dst[m][k] = *(const PG8_LAS bf16x8*)(lds + PG8_SA(b, h) + aoff + m * 2048 + k * 1024); } while (0)
#define PG8_LDB(dst, b, h) do { _Pragma("unroll") for (int n = 0; n < 2; ++n) _Pragma("unroll") for (int k = 0; k < 2; ++k) dst[n][k] = *(const PG8_LAS bf16x8*)(lds + PG8_SB(b, h) + boff + n * 2048 + k * 1024); } while (0)
#define PG8_MMA(ai, bj, At, Bt) do { __builtin_amdgcn_s_setprio(1); _Pragma("unroll") for (int m = 0; m < 4; ++m) _Pragma("unroll") for (int n = 0; n < 2; ++n) _Pragma("unroll") for (int k = 0; k < 2; ++k) \
        acc[ai][bj][m][n] = __builtin_amdgcn_mfma_f32_16x16x32_bf16(Bt[n][k], At[m][k], acc[ai][bj][m][n], 0, 0, 0); __builtin_amdgcn_s_setprio(0); } while (0)
#define PG8_WAIT_V(n) asm volatile("s_waitcnt vmcnt(" #n ")" ::: "memory")
#define PG8_WAIT_L(n) asm volatile("s_waitcnt lgkmcnt(" #n ")" ::: "memory")
#define PG8_BAR __builtin_amdgcn_s_barrier()
#define PG8_SCHED __builtin_amdgcn_sched_barrier(0)
    Unit cur, nxt; int ui = 0;
    if (!S.next(0, cur)) return;
    f32x4 acc[2][2][4][2];
#pragma unroll
    for (int a = 0; a < 2; ++a)
#pragma unroll
        for (int b = 0; b < 2; ++b)
#pragma unroll
            for (int m = 0; m < 4; ++m)
#pragma unroll
                for (int n = 0; n < 2; ++n) acc[a][b][m][n] = (f32x4){0.f, 0.f, 0.f, 0.f};
    bf16x8 At[4][2], B0[2][2], B1[2][2];
    const char* cA = cur.a; const char* cB = cur.b;
    if constexpr (SP2) {
        PG8_STAGE(PG8_SB(0, 0), cB, voffB); PG8_STAGE(PG8_SB(0, 1), cB + hstepB, voffB); PG8_STAGE(PG8_SA(0, 0), cA, voffA); PG8_STAGE(PG8_SA(0, 1), cA + hstepA, voffA);
        if (wr == 1) PG8_BAR;
        PG8_WAIT_V(2); PG8_BAR;
        PG8_STAGE(PG8_SB(1, 0), cB + kstep, voffB); PG8_STAGE(PG8_SA(1, 0), cA + kstep, voffA); PG8_STAGE(PG8_SB(1, 1), cB + hstepB + kstep, voffB);
        PG8_WAIT_V(6); PG8_BAR;
    } else {
        PG8_STAGE(PG8_SB(0, 0), cB, voffB); PG8_STAGE(PG8_SA(0, 0), cA, voffA); PG8_STAGE(PG8_SB(0, 1), cB + hstepB, voffB); PG8_STAGE(PG8_SA(0, 1), cA + hstepA, voffA);
        if (wr == 1) PG8_BAR;
        PG8_WAIT_V(4); PG8_BAR;
        PG8_STAGE(PG8_SB(1, 0), cB + kstep, voffB); PG8_STAGE(PG8_SA(1, 0), cA + kstep, voffA); PG8_STAGE(PG8_SB(1, 1), cB + hstepB + kstep, voffB);
        PG8_WAIT_V(6); PG8_BAR;
    }
    for (;;) {
        const bool has_next = S.next(ui + 1, nxt);
        const char* nA = has_next ? nxt.a : cA; const char* nB = has_next ? nxt.b : cB;
        for (int t = 0; t < nt; t += 2) {
            const bool last = (t == nt - 2);
            const char* a1 = cA + (size_t)(t + 1) * kstep;
            const char* a2 = last ? nA : cA + (size_t)(t + 2) * kstep; const char* b2 = last ? nB : cB + (size_t)(t + 2) * kstep;
            const char* a3 = a2 + kstep; const char* b3 = b2 + kstep;
            if constexpr (SP2) {
            PG8_LDB(B0, 0, 0); PG8_LDB(B1, 0, 1); PG8_SCHED; PG8_LDA(At, 0, 0); PG8_STAGE(PG8_SA(1, 1), a1 + hstepA, voffA);
            PG8_WAIT_V(8); PG8_WAIT_L(0); PG8_BAR; PG8_MMA(0, 0, At, B0); PG8_MMA(0, 1, At, B1); PG8_BAR; PG8_SCHED;
            PG8_LDA(At, 0, 1); PG8_STAGE(PG8_SB(0, 0), b2, voffB); PG8_STAGE(PG8_SB(0, 1), b2 + hstepB, voffB); PG8_STAGE(PG8_SA(0, 0), a2, voffA);
            PG8_WAIT_V(8); PG8_WAIT_L(0); PG8_BAR; PG8_MMA(1, 0, At, B0); PG8_MMA(1, 1, At, B1); PG8_BAR; PG8_SCHED;
            PG8_LDB(B0, 1, 0); PG8_LDB(B1, 1, 1); PG8_SCHED; PG8_LDA(At, 1, 0); PG8_STAGE(PG8_SA(0, 1), a2 + hstepA, voffA);
            PG8_WAIT_V(8); PG8_WAIT_L(0); PG8_BAR; PG8_MMA(0, 0, At, B0); PG8_MMA(0, 1, At, B1); PG8_BAR; PG8_SCHED;
            PG8_LDA(At, 1, 1); PG8_STAGE(PG8_SB(1, 0), b3, voffB); PG8_STAGE(PG8_SB(1, 1), b3 + hstepB, voffB); PG8_STAGE(PG8_SA(1, 0), a3, voffA);
            PG8_WAIT_V(8); PG8_WAIT_L(0); PG8_BAR; PG8_MMA(1, 0, At, B0); PG8_MMA(1, 1, At, B1); PG8_BAR; PG8_SCHED;
            } else {
            PG8_LDB(B0, 0, 0); PG8_SCHED; PG8_LDA(At, 0, 0); PG8_STAGE(PG8_SA(1, 1), a1 + hstepA, voffA);
            PG8_WAIT_L(8); PG8_BAR; PG8_WAIT_L(0); PG8_MMA(0, 0, At, B0); PG8_BAR; PG8_SCHED;
            PG8_LDB(B1, 0, 1); PG8_STAGE(PG8_SB(0, 0), b2, voffB);
            PG8_BAR; PG8_WAIT_L(0); PG8_MMA(0, 1, At, B1); PG8_BAR;
            PG8_LDA(At, 0, 1); PG8_STAGE(PG8_SA(0, 0), a2, voffA);
            PG8_BAR; PG8_WAIT_L(0); PG8_MMA(1, 0, At, B0); PG8_BAR; PG8_SCHED;
            PG8_STAGE(PG8_SB(0, 1), b2 + hstepB, voffB);
            PG8_WAIT_V(6); PG8_BAR; PG8_MMA(1, 1, At, B1); PG8_BAR;
            PG8_LDB(B0, 1, 0); PG8_SCHED; PG8_LDA(At, 1, 0); PG8_STAGE(PG8_SA(0, 1), a2 + hstepA, voffA);
            PG8_WAIT_L(8); PG8_BAR; PG8_WAIT_L(0); PG8_MMA(0, 0, At, B0); PG8_BAR; PG8_SCHED;
            PG8_LDB(B1, 1, 1); PG8_STAGE(PG8_SB(1, 0), b3, voffB);
            PG8_BAR; PG8_WAIT_L(0); PG8_MMA(0, 1, At, B1); PG8_BAR;
            PG8_LDA(At, 1, 1); PG8_STAGE(PG8_SA(1, 0), a3, voffA);
            PG8_BAR; PG8_WAIT_L(0); PG8_MMA(1, 0, At, B0); PG8_BAR; PG8_SCHED;
            PG8_STAGE(PG8_SB(1, 1), b3 + hstepB, voffB);
            PG8_WAIT_V(6); PG8_BAR; PG8_MMA(1, 1, At, B1); PG8_BAR;
            }
        }
        if constexpr (ALIGN_EPI) { if (wr == 0) PG8_BAR; }
        E(acc, cur, wr, wc, fr, fq);
        if (!has_next) break;
#pragma unroll
        for (int a = 0; a < 2; ++a)
#pragma unroll
            for (int b = 0; b < 2; ++b)
#pragma unroll
                for (int m = 0; m < 4; ++m)
#pragma unroll
                    for (int n = 0; n < 2; ++n) acc[a][b][m][n] = (f32x4){0.f, 0.f, 0.f, 0.f};
        cur = nxt; cA = nA; cB = nB; ++ui;
        if constexpr (ALIGN_EPI) { if (wr == 1) PG8_BAR; }
    }
    PG8_WAIT_V(0);
    if constexpr (!ALIGN_EPI) { if (wr == 0) PG8_BAR; }
    PG8_BAR;
#undef PG8_SA
#undef PG8_SB
#undef PG8_STAGE
#undef PG8_LDA
#undef PG8_LDB
#undef PG8_MMA
#undef PG8_WAIT_V
#undef PG8_WAIT_L
#undef PG8_BAR
#undef PG8_SCHED
}
}

constexpr int NWAVES = 8;
constexpr int BATCH = 16, SEQ = 2048, DM = 1024, T = BATCH * SEQ, MEML = 256, TM = BATCH * MEML;
constexpr int INW = 5888, DFF = 2816, NGU = 2 * DFF;
constexpr int C_QA = 0, C_KA = 512, C_VA = 640, C_QB = 768, C_KB = 1280, C_VB = 1792, C_QM = 2304, C_G = 2816;
constexpr float EPS = 1e-6f;
constexpr int N_PHASES = 9;

constexpr size_t MiB = 1u << 20;
constexpr size_t WS_CTL = 0, CTL_ZERO_BYTES = 64 * 1024;
constexpr size_t WS_WIN = 1 * MiB, WS_WMKV = 13 * MiB, WS_WBR = 15 * MiB, WS_WOUT = 18 * MiB, WS_WGU = 20 * MiB, WS_WDN = 31 * MiB, WS_BIAS = 37 * MiB;
constexpr size_t WS_MN = 40 * MiB, WS_MKV = 48 * MiB, WS_XN = 56 * MiB  , WS_PROJ = 120 * MiB;
constexpr size_t WS_MIX = 120 * MiB  , WS_XN2 = 248 * MiB, WS_A = 312 * MiB, WS_END = 488 * MiB;
static_assert(WS_PROJ + (size_t)T * INW * 2 <= WS_END && WS_A + (size_t)T * DFF * 2 <= WS_END && WS_XN2 + (size_t)T * DM * 2 <= WS_A && WS_MIX + (size_t)T * DM * 4 <= WS_XN2, "d_ws map");
static_assert(WS_WIN + (size_t)INW * DM * 2 <= WS_WMKV && WS_WGU + (size_t)NGU * DM * 2 <= WS_WDN && WS_WDN + (size_t)DM * DFF * 2 <= WS_BIAS, "d_ws weight map");

constexpr int LDS_BYTES = 147456;
constexpr int LDS_MISC = 131072 + 1024;
constexpr int CW_BAR = 4096;

__device__ const unsigned char T5B[128] = {0, 1, 2, 3, 4, 5, 6, 7, 8, 9, 10, 11, 12, 13, 14, 15, 16, 16, 16, 17, 17, 18, 18, 18, 19, 19, 19, 20, 20, 20, 20, 21, 21, 21, 21, 22, 22, 22, 22, 22, 23, 23, 23, 23, 23, 23, 24, 24, 24, 24, 24, 24, 25, 25, 25, 25, 25, 25, 25, 26, 26, 26, 26, 26, 26, 26, 26, 27, 27, 27, 27, 27, 27, 27, 27, 27, 27, 28, 28, 28, 28, 28, 28, 28, 28, 28, 28, 29, 29, 29, 29, 29, 29, 29, 29, 29, 29, 29, 29, 30, 30, 30, 30, 30, 30, 30, 30, 30, 30, 30, 30, 30, 30, 31, 31, 31, 31, 31, 31, 31, 31, 31, 31, 31, 31, 31, 31, 31};

#define LAS __attribute__((address_space(3)))
typedef unsigned short bf16;
typedef unsigned v4u __attribute__((ext_vector_type(4)));
typedef unsigned v2u __attribute__((ext_vector_type(2)));
typedef float f32x4 __attribute__((ext_vector_type(4)));
#define LDS_WAIT() asm volatile("s_waitcnt lgkmcnt(0)" ::: "memory")
__device__ __forceinline__ unsigned f2bf(float f) { unsigned u = __builtin_bit_cast(unsigned, f); return (u + 0x7fffu + ((u >> 16) & 1u)) >> 16; }
__device__ __forceinline__ unsigned pk2(float lo, float hi) { return f2bf(lo) | (f2bf(hi) << 16); }
__device__ __forceinline__ float bflo(unsigned u) { return __builtin_bit_cast(float, u << 16); }
__device__ __forceinline__ float bfhi(unsigned u) { return __builtin_bit_cast(float, u & 0xffff0000u); }
__device__ __forceinline__ float bf1(bf16 h) { return __builtin_bit_cast(float, (unsigned)h << 16); }
__device__ __forceinline__ float wave_sum(float v) {
#pragma unroll
    for (int o = 1; o < 64; o <<= 1) v += __shfl_xor(v, o);
    return v;
}
__device__ __forceinline__ float wave_max(float v) {
#pragma unroll
    for (int o = 1; o < 64; o <<= 1) v = fmaxf(v, __shfl_xor(v, o));
    return v;
}
__device__ __forceinline__ float dot8(v4u a, v4u b) {
    float s = bflo(a.x) * bflo(b.x); s += bfhi(a.x) * bfhi(b.x); s += bflo(a.y) * bflo(b.y); s += bfhi(a.y) * bfhi(b.y);
    s += bflo(a.z) * bflo(b.z); s += bfhi(a.z) * bfhi(b.z); s += bflo(a.w) * bflo(b.w); s += bfhi(a.w) * bfhi(b.w); return s;
}
__device__ __forceinline__ float sigmoidf_(float x) { return 1.0f / (1.0f + __expf(-x)); }

struct Frame {
    LAS unsigned char* lds;
    int tid, lane, wave, G, gw, ngw;
    const float *x, *mem, *ln_mix_pre, *ln_mix_post, *w_in, *sinks, *rel_bias, *ln_mem, *w_mem_kv, *w_br0, *w_br1, *w_br2, *w_out, *ln_ffn_pre, *ln_ffn_post, *w_gate, *w_up, *w_down;
    float* out;
    bf16 *WinT, *WmkvT, *WbrT, *WoutT, *WguT, *WdnT, *MN, *MKV, *XN, *MERGED, *PROJ, *XN2, *AH;
    float *BIAS, *MIX;
};

__device__ __forceinline__ void p0_transpose_item(const float* W, int K, int N, bf16* WT, int drow0, int k0, int n0, LAS float* scr, int lane) {
#pragma unroll 8
    for (int i = 0; i < 32; ++i) { const int kk = 2 * i + (lane >> 5); scr[kk * 33 + (lane & 31)] = W[(size_t)(k0 + kk) * N + n0 + (lane & 31)]; }
    LDS_WAIT(); asm volatile("" ::: "memory");
    const int c = lane & 7;
#pragma unroll
    for (int j = 0; j < 4; ++j) { const int n = (lane >> 3) + 8 * j; const LAS float* s = scr + (8 * c) * 33 + n;
        v4u o; o.x = pk2(s[0 * 33], s[1 * 33]); o.y = pk2(s[2 * 33], s[3 * 33]); o.z = pk2(s[4 * 33], s[5 * 33]); o.w = pk2(s[6 * 33], s[7 * 33]);
        *(v4u*)(WT + (size_t)(drow0 + n) * K + k0 + 8 * c) = o; }
    LDS_WAIT(); asm volatile("" ::: "memory");
}
__device__ __forceinline__ void rms_row_to_bf16(const float* xrow, const float* g, bf16* orow, int lane) {
    const f32x4* xr = (const f32x4*)xrow + lane; const f32x4* gr = (const f32x4*)g + lane;
    f32x4 v[4]; float s = 0.f;
#pragma unroll
    for (int j = 0; j < 4; ++j) { v[j] = xr[64 * j]; s += (v[j].x * v[j].x + v[j].y * v[j].y) + (v[j].z * v[j].z + v[j].w * v[j].w); }
    const float rstd = 1.0f / sqrtf(wave_sum(s) * (1.f / DM) + EPS);
    v2u* o8 = (v2u*)orow + lane;
#pragma unroll
    for (int j = 0; j < 4; ++j) { const f32x4 gg = gr[64 * j]; v2u w; w.x = pk2(v[j].x * rstd * gg.x, v[j].y * rstd * gg.y); w.y = pk2(v[j].z * rstd * gg.z, v[j].w * rstd * gg.w); o8[64 * j] = w; }
}

__device__ __forceinline__ void phase_prologue(Frame& F) {
    LAS float* scr = (LAS float*)(F.lds + F.wave * 16384);
    constexpr int I_IN = (DM / 64) * (INW / 32), I_MKV = (DM / 64) * (DM / 32), I_BR = (512 / 64) * (DM / 32), I_OUT = I_MKV, I_G = (DM / 64) * (DFF / 32), I_D = (DFF / 64) * (DM / 32);
    constexpr int NITEMS = I_IN + I_MKV + 3 * I_BR + I_OUT + 2 * I_G + I_D;
    for (int it = F.gw; it < NITEMS; it += F.ngw) {
        int r = it;
        if (r < I_IN) { const int nb = r % (INW / 32), kb = r / (INW / 32); p0_transpose_item(F.w_in, DM, INW, F.WinT, 32 * nb, 64 * kb, 32 * nb, scr, F.lane); continue; } r -= I_IN;
        if (r < I_MKV) { const int nb = r % (DM / 32), kb = r / (DM / 32); p0_transpose_item(F.w_mem_kv, DM, DM, F.WmkvT, 32 * nb, 64 * kb, 32 * nb, scr, F.lane); continue; } r -= I_MKV;
        if (r < I_BR) { const int nb = r % (DM / 32), kb = r / (DM / 32); p0_transpose_item(F.w_br0, 512, DM, F.WbrT, 32 * nb, 64 * kb, 32 * nb, scr, F.lane); continue; } r -= I_BR;
        if (r < I_BR) { const int nb = r % (DM / 32), kb = r / (DM / 32); p0_transpose_item(F.w_br1, 512, DM, F.WbrT + (size_t)DM * 512, 32 * nb, 64 * kb, 32 * nb, scr, F.lane); continue; } r -= I_BR;
        if (r < I_BR) { const int nb = r % (DM / 32), kb = r / (DM / 32); p0_transpose_item(F.w_br2, 512, DM, F.WbrT + (size_t)2 * DM * 512, 32 * nb, 64 * kb, 32 * nb, scr, F.lane); continue; } r -= I_BR;
        if (r < I_OUT) { const int nb = r % (DM / 32), kb = r / (DM / 32); p0_transpose_item(F.w_out, DM, DM, F.WoutT, 32 * nb, 64 * kb, 32 * nb, scr, F.lane); continue; } r -= I_OUT;
        if (r < I_G) { const int nb = r % (DFF / 32), kb = r / (DFF / 32), n0 = 32 * nb;
            p0_transpose_item(F.w_gate, DM, DFF, F.WguT, (n0 / 128) * 256 + (n0 % 128), 64 * kb, n0, scr, F.lane); continue; } r -= I_G;
        if (r < I_G) { const int nb = r % (DFF / 32), kb = r / (DFF / 32), n0 = 32 * nb;
            p0_transpose_item(F.w_up, DM, DFF, F.WguT, (n0 / 128) * 256 + 128 + (n0 % 128), 64 * kb, n0, scr, F.lane); continue; } r -= I_G;
        { const int nb = r % (DM / 32), kb = r / (DM / 32); p0_transpose_item(F.w_down, DFF, DM, F.WdnT, 32 * nb, 64 * kb, 32 * nb, scr, F.lane); }
    }
    for (int m = F.gw; m < T; m += F.ngw) rms_row_to_bf16(F.x + (size_t)m * DM, F.ln_mix_pre, F.XN + (size_t)m * DM, F.lane);
    for (int m = F.gw; m < TM; m += F.ngw) rms_row_to_bf16(F.mem + (size_t)m * DM, F.ln_mem, F.MN + (size_t)m * DM, F.lane);
    for (int i = blockIdx.x * (NWAVES * 64) + F.tid; i < 128 * 8; i += F.G * NWAVES * 64) F.BIAS[i] = F.rel_bias[(int)T5B[i >> 3] * 8 + (i & 7)];
}

struct SchedProj {
    int G, c; const char *XN, *MN, *WinT, *WmkvT;
    __device__ __forceinline__ bool next(int i, pg8::Unit& u) const {
        const int L = i * G + c; constexpr int N1 = (T / 256) * (INW / 256), N2 = (TM / 256) * (DM / 256);
        if (L < N1) { pg8::tile_of(L, T / 256, INW / 256, u.pm, u.pn); u.z = 0; u.a = XN + (size_t)u.pm * 256 * DM * 2; u.b = WinT + (size_t)u.pn * 256 * DM * 2; return true; }
        if (L < N1 + N2) { const int l = L - N1; u.pm = l >> 2; u.pn = l & 3; u.z = 1; u.a = MN + (size_t)u.pm * 256 * DM * 2; u.b = WmkvT + (size_t)u.pn * 256 * DM * 2; return true; }
        return false;
    }
};
struct EpiProj {
    static constexpr bool PERM = true;
    bf16 *PROJ, *MKV;
    __device__ __forceinline__ void operator()(const pg8::f32x4 (&acc)[2][2][4][2], const pg8::Unit& u, int wr, int wc, int fr, int fq) const {
        bf16* base = u.z ? MKV : PROJ; const int ldc = u.z ? DM : INW; const bool sig = (u.z == 0) && (u.pn * 256 >= C_G);
        const int row0 = u.pm * 256 + wr * 64 + fr, col0 = u.pn * 256 + wc * 32 + 8 * fq;
#pragma unroll
        for (int ai = 0; ai < 2; ++ai)
#pragma unroll
            for (int m = 0; m < 4; ++m) { bf16* rowp = base + (size_t)(row0 + ai * 128 + m * 16) * ldc + col0;
#pragma unroll
                for (int bj = 0; bj < 2; ++bj) { pg8::f32x4 v0 = acc[ai][bj][m][0], v1 = acc[ai][bj][m][1];
                    if (sig) {
#pragma unroll
                        for (int e = 0; e < 4; ++e) { v0[e] = sigmoidf_(v0[e]); v1[e] = sigmoidf_(v1[e]); } }
                    pg8::u32x4 w; w.x = pg8::cvt_pk_bf16(v0[0], v0[1]); w.y = pg8::cvt_pk_bf16(v0[2], v0[3]); w.z = pg8::cvt_pk_bf16(v1[0], v1[1]); w.w = pg8::cvt_pk_bf16(v1[2], v1[3]);
                    *(pg8::u32x4*)(rowp + bj * 128) = w; } }
    }
};
struct SchedMerge {
    int G, c; const char *PROJ, *WbrT;
    __device__ __forceinline__ bool next(int i, pg8::Unit& u) const {
        const int ti = i / 3, z = i - 3 * ti, L = ti * G + c;
        if (L >= (T / 256) * (DM / 256)) return false;
        pg8::tile_of(L, T / 256, DM / 256, u.pm, u.pn); u.z = z;
        const int ycol = z == 0 ? C_QA : (z == 1 ? C_QB : C_QM);
        u.a = PROJ + ((size_t)u.pm * 256 * INW + ycol) * 2; u.b = WbrT + ((size_t)z * DM * 512 + (size_t)u.pn * 256 * 512) * 2; return true;
    }
};
struct EpiMerge {
    static constexpr bool PERM = true;
    const bf16* PROJ; bf16* MERGED;
    __device__ __forceinline__ void operator()(const pg8::f32x4 (&acc)[2][2][4][2], const pg8::Unit& u, int wr, int wc, int fr, int fq) const {
        const int row0 = u.pm * 256 + wr * 64 + fr, col0 = u.pn * 256 + wc * 32 + 8 * fq;
        const bool rmw = (u.z != 0);
#pragma unroll
        for (int ai = 0; ai < 2; ++ai) {
            pg8::u32x4 gq[4][2], mq[4][2];
#pragma unroll
            for (int m = 0; m < 4; ++m) { const size_t row = (size_t)(row0 + ai * 128 + m * 16);
#pragma unroll
                for (int bj = 0; bj < 2; ++bj) { const int col = col0 + bj * 128;
                    gq[m][bj] = *(const pg8::u32x4*)(PROJ + row * INW + C_G + u.z * DM + col);
                    if (rmw) mq[m][bj] = *(const pg8::u32x4*)(MERGED + row * DM + col); else mq[m][bj] = (pg8::u32x4){0u, 0u, 0u, 0u}; } }
#pragma unroll
            for (int m = 0; m < 4; ++m) { const size_t row = (size_t)(row0 + ai * 128 + m * 16);
#pragma unroll
                for (int bj = 0; bj < 2; ++bj) { const int col = col0 + bj * 128; const pg8::u32x4 g4 = gq[m][bj], m4 = mq[m][bj];
                    pg8::f32x4 v0 = acc[ai][bj][m][0], v1 = acc[ai][bj][m][1];
                    v0[0] = v0[0] * bflo(g4.x) + bflo(m4.x); v0[1] = v0[1] * bfhi(g4.x) + bfhi(m4.x); v0[2] = v0[2] * bflo(g4.y) + bflo(m4.y); v0[3] = v0[3] * bfhi(g4.y) + bfhi(m4.y);
                    v1[0] = v1[0] * bflo(g4.z) + bflo(m4.z); v1[1] = v1[1] * bfhi(g4.z) + bfhi(m4.z); v1[2] = v1[2] * bflo(g4.w) + bflo(m4.w); v1[3] = v1[3] * bfhi(g4.w) + bfhi(m4.w);
                    pg8::u32x4 w; w.x = pg8::cvt_pk_bf16(v0[0], v0[1]); w.y = pg8::cvt_pk_bf16(v0[2], v0[3]); w.z = pg8::cvt_pk_bf16(v1[0], v1[1]); w.w = pg8::cvt_pk_bf16(v1[2], v1[3]);
                    *(pg8::u32x4*)(MERGED + row * DM + col) = w; } }
            asm volatile("" ::: "memory");
        }
    }
};
struct SchedPlain {
    int G, c, nM, nN; const char *A, *Bt; size_t astep, bstep;
    __device__ __forceinline__ bool next(int i, pg8::Unit& u) const {
        const int L = i * G + c; if (L >= nM * nN) return false;
        pg8::tile_of(L, nM, nN, u.pm, u.pn); u.z = 0; u.a = A + (size_t)u.pm * astep; u.b = Bt + (size_t)u.pn * bstep; return true;
    }
};
struct EpiF32 {
    static constexpr bool PERM = false;
    float* C; int ldc;
    __device__ __forceinline__ void operator()(const pg8::f32x4 (&acc)[2][2][4][2], const pg8::Unit& u, int wr, int wc, int fr, int fq) const {
        const int row0 = u.pm * 256 + wr * 64 + fr, col0 = u.pn * 256 + wc * 32 + 4 * fq;
#pragma unroll
        for (int ai = 0; ai < 2; ++ai)
#pragma unroll
            for (int m = 0; m < 4; ++m) { float* rowp = C + (size_t)(row0 + ai * 128 + m * 16) * ldc + col0;
#pragma unroll
                for (int bj = 0; bj < 2; ++bj)
#pragma unroll
                    for (int n = 0; n < 2; ++n) *(pg8::f32x4*)(rowp + bj * 128 + n * 16) = acc[ai][bj][m][n]; }
    }
};
struct EpiSwiGLU {
    static constexpr bool PERM = true;
    bf16* AH;
    __device__ __forceinline__ void operator()(const pg8::f32x4 (&acc)[2][2][4][2], const pg8::Unit& u, int wr, int wc, int fr, int fq) const {
        const int row0 = u.pm * 256 + wr * 64 + fr, col0 = u.pn * 128 + wc * 32 + 8 * fq;
#pragma unroll
        for (int ai = 0; ai < 2; ++ai)
#pragma unroll
            for (int m = 0; m < 4; ++m) { bf16* rowp = AH + (size_t)(row0 + ai * 128 + m * 16) * DFF + col0;
                float o[8];
#pragma unroll
                for (int n = 0; n < 2; ++n)
#pragma unroll
                    for (int e = 0; e < 4; ++e) { const float gv = acc[ai][0][m][n][e], uv = acc[ai][1][m][n][e]; o[4 * n + e] = gv * sigmoidf_(gv) * uv; }
                pg8::u32x4 w; w.x = pg8::cvt_pk_bf16(o[0], o[1]); w.y = pg8::cvt_pk_bf16(o[2], o[3]); w.z = pg8::cvt_pk_bf16(o[4], o[5]); w.w = pg8::cvt_pk_bf16(o[6], o[7]);
                *(pg8::u32x4*)rowp = w; }
    }
};

__device__ __forceinline__ void attn_swa_row(Frame& F, int row, int hq) {
    const int lane = F.lane, t = row % SEQ, kvh = hq >> 2;
    const bf16* qp = F.PROJ + (size_t)row * INW + C_QA + hq * 64;
    v4u q[8];
#pragma unroll
    for (int i = 0; i < 8; ++i) q[i] = *(const v4u*)(qp + 8 * i);
    float sc[2]; bool val[2];
#pragma unroll
    for (int j = 0; j < 2; ++j) { const int dist = lane + 64 * j, s = t - dist; val[j] = s >= 0; sc[j] = -INFINITY;
        if (val[j]) { const bf16* kp = F.PROJ + (size_t)(row - dist) * INW + C_KA + kvh * 64; float a = 0.f;
#pragma unroll
            for (int i = 0; i < 8; ++i) a += dot8(q[i], *(const v4u*)(kp + 8 * i));
            sc[j] = a * 0.125f + F.BIAS[dist * 8 + hq]; } }
    const float sink = F.sinks[hq];
    const float mx = fmaxf(wave_max(fmaxf(sc[0], sc[1])), sink);
    float p0 = val[0] ? __expf(sc[0] - mx) : 0.f, p1 = val[1] ? __expf(sc[1] - mx) : 0.f;
    const float den = wave_sum(p0 + p1) + __expf(sink - mx);
    p0 /= den; p1 /= den;
    float y = 0.f; const int nk = t < 127 ? t + 1 : 128;
    const bf16* vp = F.PROJ + (size_t)row * INW + C_VA + kvh * 64 + lane;
    for (int d = 0; d < nk; ++d) { const float w = __shfl(d < 64 ? p0 : p1, d & 63); y += w * bf1(vp[-(ptrdiff_t)d * INW]); }
    ((bf16*)qp)[lane] = (bf16)f2bf(y);
}
__device__ __forceinline__ void attn_sb_row(Frame& F, int row, int h) {
    const int lane = F.lane, t = row % SEQ;
    const bf16* qp = F.PROJ + (size_t)row * INW + C_QB + h * 64;
    v4u q[8];
#pragma unroll
    for (int i = 0; i < 8; ++i) q[i] = *(const v4u*)(qp + 8 * i);
    float carry = 1.f, y = 0.f;
    for (int base = t - 1; base >= 0 && carry != 0.f; base -= 64) {
        const int s = base - lane; const bool valid = s >= 0;
        float beta = 0.f, c = 1.f;
        if (valid) { const bf16* kp = F.PROJ + (size_t)(row - t + s) * INW + C_KB + h * 64; float a = 0.f;
#pragma unroll
            for (int i = 0; i < 8; ++i) a += dot8(q[i], *(const v4u*)(kp + 8 * i));
            const float z = fmaxf(a * 0.125f, -80.f), e = __expf(-z); beta = 1.0f / (1.0f + e); c = e * beta; }
        float incl = c;
#pragma unroll
        for (int o = 1; o < 64; o <<= 1) { const float tq = __shfl_up(incl, o); if (lane >= o) incl *= tq; }
        float excl = __shfl_up(incl, 1); if (lane == 0) excl = 1.f;
        const float a = beta * excl * carry;
        carry *= __shfl(incl, 63);
        const int nv = base + 1 < 64 ? base + 1 : 64;
        const bf16* vp = F.PROJ + (size_t)(row - t + base) * INW + C_VB + h * 64 + lane;
        for (int j = 0; j < nv; ++j) { const float w = __shfl(a, j); y += w * bf1(vp[-(ptrdiff_t)j * INW]); }
    }
    ((bf16*)qp)[lane] = (bf16)f2bf(y);
}
__device__ __forceinline__ void attn_mem_row(Frame& F, int row, int h) {
    const int lane = F.lane, b = row / SEQ;
    const bf16* qp = F.PROJ + (size_t)row * INW + C_QM + h * 128;
    v4u q[16];
#pragma unroll
    for (int i = 0; i < 16; ++i) q[i] = *(const v4u*)(qp + 8 * i);
    float sc[4];
#pragma unroll
    for (int j = 0; j < 4; ++j) { const bf16* kp = F.MKV + (size_t)(b * MEML + lane + 64 * j) * DM + h * 128; float a = 0.f;
#pragma unroll
        for (int i = 0; i < 16; ++i) a += dot8(q[i], *(const v4u*)(kp + 8 * i));
        sc[j] = a * 0.08838834764831845f; }
    const float mx = wave_max(fmaxf(fmaxf(sc[0], sc[1]), fmaxf(sc[2], sc[3])));
    float p[4]; float ps = 0.f;
#pragma unroll
    for (int j = 0; j < 4; ++j) { p[j] = __expf(sc[j] - mx); ps += p[j]; }
    const float den = wave_sum(ps);
    float y0 = 0.f, y1 = 0.f;
    const bf16* vp = F.MKV + (size_t)(b * MEML) * DM + 512 + h * 128 + lane;
#pragma unroll
    for (int j = 0; j < 4; ++j)
        for (int m = 0; m < 64; ++m) { const float w = __shfl(p[j], m); const bf16* v = vp + (size_t)(64 * j + m) * DM; y0 += w * bf1(v[0]); y1 += w * bf1(v[64]); }
    ((bf16*)qp)[lane] = (bf16)f2bf(y0 / den); ((bf16*)qp)[lane + 64] = (bf16)f2bf(y1 / den);
}
#ifndef ATTN_MFMA_SB
#define ATTN_MFMA_SB 1
#endif
#ifndef ATTN_MFMA_SWA
#define ATTN_MFMA_SWA 1
#endif
#ifndef ATTN_MFMA_MEM
#define ATTN_MFMA_MEM 1
#endif
namespace at {
typedef short bf16x8 __attribute__((ext_vector_type(8)));
typedef float f32x16 __attribute__((ext_vector_type(16)));
typedef short s16x4 __attribute__((ext_vector_type(4)));
typedef float f32x2_t __attribute__((ext_vector_type(2)));
typedef __bf16 bf16x2_t __attribute__((ext_vector_type(2)));
constexpr float LOG2E = 1.4426950408889634f;
constexpr int LDS_V = 0, LDS_SC = 65536, LDS_TB = 65536 + 8 * 256, TB_N = 192;
__device__ __forceinline__ unsigned cvtpk(float lo, float hi) { f32x2_t v = {lo, hi}; bf16x2_t b = __builtin_convertvector(v, bf16x2_t); return __builtin_bit_cast(unsigned, b); }
__device__ __forceinline__ int kperm(int r) { return 16 * ((r >> 2) & 1) + 4 * (r >> 3) + (r & 3); }
__device__ __forceinline__ int crow(int i, int h) { return (i & 3) + 8 * (i >> 2) + 4 * h; }
__device__ __forceinline__ float xhalf(float v) { return __shfl_xor(v, 32); }
#define AT_MFMA(a, b, c) __builtin_amdgcn_mfma_f32_32x32x16_bf16((a), (b), (c), 0, 0, 0)

template <int D> __device__ __forceinline__ void load_q(bf16x8 (&qf)[D / 16], const bf16* Q, size_t pitch, int q0, int lane) {
    const bf16* p = Q + (size_t)(q0 + (lane & 31)) * pitch + 8 * (lane >> 5);
#pragma unroll
    for (int s = 0; s < D / 16; ++s) qf[s] = *(const bf16x8*)(p + 16 * s);
}
template <int D> __device__ __forceinline__ void load_k(bf16x8 (&kf)[D / 16], const bf16* K, size_t pitch, int k0, int lane) {
    const bf16* p = K + (size_t)(k0 + kperm(lane & 31)) * pitch + 8 * (lane >> 5);
#pragma unroll
    for (int s = 0; s < D / 16; ++s) kf[s] = *(const bf16x8*)(p + 16 * s);
}
template <int D> __device__ __forceinline__ f32x16 qk(const bf16x8 (&kf)[D / 16], const bf16x8 (&qf)[D / 16]) {
    f32x16 acc;
#pragma unroll
    for (int i = 0; i < 16; ++i) acc[i] = 0.f;
#pragma unroll
    for (int s = 0; s < D / 16; ++s) acc = AT_MFMA(kf[s], qf[s], acc);
    return acc;
}
template <int D> __device__ __forceinline__ void load_v(v4u (&vr)[D / 16], const bf16* V, size_t pitch, int k0, int lane) {
#pragma unroll
    for (int w = 0; w < D / 16; ++w) { const int ci = lane + 64 * w, kk = ci / (D / 8), c = ci % (D / 8); vr[w] = *(const v4u*)(V + (size_t)(k0 + kk) * pitch + 8 * c); }
}
template <int D> __device__ __forceinline__ int vswz(int kk) { return D == 64 ? (((kk >> 1) & 1) << 2) : ((kk & 3) << 2); }
template <int D> __device__ __forceinline__ void store_v(const v4u (&vr)[D / 16], LAS unsigned char* vl, int lane) {
#pragma unroll
    for (int w = 0; w < D / 16; ++w) { const int ci = lane + 64 * w, kk = ci / (D / 8), c = ci % (D / 8); *(LAS v4u*)(vl + kk * (D * 2) + ((c ^ vswz<D>(kk)) << 4)) = vr[w]; }
}
__device__ __forceinline__ s16x4 vtr(LAS unsigned char* p) { typedef short v4i16_t __attribute__((ext_vector_type(4))); return __builtin_bit_cast(s16x4, __builtin_amdgcn_ds_read_tr16_b64_v4i16((LAS v4i16_t*)p)); }
template <int D> __device__ __forceinline__ void pv(f32x16 (&o)[D / 32], const bf16x8 (&pa)[2], LAS unsigned char* vl, int lane) {
    const int g = lane >> 4, q = (lane & 15) >> 2, p = lane & 3, h = g >> 1;
#pragma unroll
    for (int db = 0; db < D / 32; ++db)
#pragma unroll
        for (int s = 0; s < 2; ++s) {
            s16x4 t[2];
#pragma unroll
            for (int u = 0; u < 2; ++u) { const int kk = 16 * h + 8 * s + 4 * u + q, chunk = db * 4 + 2 * (g & 1) + (p >> 1);
                t[u] = vtr(vl + kk * (D * 2) + ((chunk ^ vswz<D>(kk)) << 4) + (p & 1) * 8); }
            const bf16x8 vf = (bf16x8){t[0][0], t[0][1], t[0][2], t[0][3], t[1][0], t[1][1], t[1][2], t[1][3]};
            o[db] = AT_MFMA(pa[s], vf, o[db]);
        }
}
__device__ __forceinline__ void pack_p(bf16x8 (&pa)[2], const float (&a)[16]) {
#pragma unroll
    for (int s = 0; s < 2; ++s) { v4u w; w.x = cvtpk(a[8 * s], a[8 * s + 1]); w.y = cvtpk(a[8 * s + 2], a[8 * s + 3]); w.z = cvtpk(a[8 * s + 4], a[8 * s + 5]); w.w = cvtpk(a[8 * s + 6], a[8 * s + 7]); pa[s] = __builtin_bit_cast(bf16x8, w); }
}
template <int D> __device__ __forceinline__ void store_o(const f32x16 (&o)[D / 32], bf16* Y, size_t pitch, int q0, int lane, const LAS float* sc) {
    const int d = lane & 31, hh = lane >> 5;
#pragma unroll
    for (int i = 0; i < 16; ++i) { const int qr = crow(i, hh); const float f = sc ? sc[qr] : 1.f; bf16* yp = Y + (size_t)(q0 + qr) * pitch + d;
#pragma unroll
        for (int db = 0; db < D / 32; ++db) yp[db * 32] = (bf16)f2bf(o[db][i] * f); }
}

__device__ __forceinline__ void sb_block(const bf16* Qh, const bf16* Kh, const bf16* Vh, bf16* Yh, int q0, LAS unsigned char* vl, int lane) {
    constexpr int D = 64; constexpr float C1 = 0.125f * LOG2E;
    const int n = lane & 31, h = lane >> 5;
    bf16x8 qf[4]; load_q<D>(qf, Qh, INW, q0, lane);
    f32x16 o[2];
#pragma unroll
    for (int i = 0; i < 16; ++i) { o[0][i] = 0.f; o[1][i] = 0.f; }
    float carry = 1.f;
    bf16x8 kf[4]; v4u vr[4];
    load_k<D>(kf, Kh, INW, q0, lane); load_v<D>(vr, Vh, INW, q0, lane);
    for (int k0 = q0; k0 >= 0; k0 -= 32) {
        const f32x16 S = qk<D>(kf, qf);
        store_v<D>(vr, vl, lane);
        if (k0 >= 32) { load_k<D>(kf, Kh, INW, k0 - 32, lane); load_v<D>(vr, Vh, INW, k0 - 32, lane); }
        const bool diag = (k0 == q0);
        float bp[16]; float P = 1.f;
#pragma unroll
        for (int i = 15; i >= 0; --i) {
            const float z = fmaxf(S[i] * C1, -100.f), e = __builtin_amdgcn_exp2f(-z);
            float b = __builtin_amdgcn_rcpf(1.0f + e), c = e * b;
            if (diag && (16 * h + i >= n)) { b = 0.f; c = 1.f; }
            bp[i] = b * P; P *= c;
        }
        const float To = xhalf(P);
        const float cl = h ? carry : carry * To;
        float a[16];
#pragma unroll
        for (int i = 0; i < 16; ++i) a[i] = bp[i] * cl;
        carry = carry * P * To;
        bf16x8 pa[2]; pack_p(pa, a);
        pv<D>(o, pa, vl, lane);
        if (__ballot(carry != 0.f) == 0ull) break;
    }
    store_o<D>(o, Yh, INW, q0, lane, nullptr);
}

__device__ __forceinline__ void swa_block(const bf16* Qh, const bf16* Kh, const bf16* Vh, bf16* Yh, int q0, float sink2, const LAS float* tb  , LAS unsigned char* vl, LAS float* sc, int lane) {
    constexpr int D = 64; constexpr float C1 = 0.125f * LOG2E;
    const int n = lane & 31, h = lane >> 5;
    bf16x8 qf[4]; load_q<D>(qf, Qh, INW, q0, lane);
    const int klo = q0 >= 128 ? q0 - 128 : 0;
    bf16x8 kf[4];
    float m = sink2;
    for (int k0 = klo; k0 <= q0; k0 += 32) {
        load_k<D>(kf, Kh, INW, k0, lane);
        const f32x16 S = qk<D>(kf, qf);
        const int dl = q0 - k0; const LAS float* tp = tb + (dl + n - 16 * h + 32 - 15);
#pragma unroll
        for (int i = 0; i < 16; ++i) { const int dist = dl + n - 16 * h - i; const float sv = S[i] * C1 + tp[15 - i]; if (dist >= 0 && dist < 128) m = fmaxf(m, sv); }
    }
    m = fmaxf(m, xhalf(m));
    f32x16 o[2];
#pragma unroll
    for (int i = 0; i < 16; ++i) { o[0][i] = 0.f; o[1][i] = 0.f; }
    float l = 0.f; v4u vr[4];
    for (int k0 = klo; k0 <= q0; k0 += 32) {
        load_k<D>(kf, Kh, INW, k0, lane); load_v<D>(vr, Vh, INW, k0, lane);
        const f32x16 S = qk<D>(kf, qf);
        store_v<D>(vr, vl, lane);
        const int dl = q0 - k0; const LAS float* tp = tb + (dl + n - 16 * h + 32 - 15);
        float a[16];
#pragma unroll
        for (int i = 0; i < 16; ++i) { const int dist = dl + n - 16 * h - i; const float sv = S[i] * C1 + tp[15 - i]; a[i] = (dist >= 0 && dist < 128) ? __builtin_amdgcn_exp2f(sv - m) : 0.f; l += a[i]; }
        bf16x8 pa[2]; pack_p(pa, a);
        pv<D>(o, pa, vl, lane);
    }
    l += xhalf(l); l += __builtin_amdgcn_exp2f(sink2 - m);
    if (h == 0) sc[n] = 1.0f / l;
    LDS_WAIT();
    store_o<D>(o, Yh, INW, q0, lane, sc);
    LDS_WAIT();
}

__device__ __forceinline__ void mem_block(const bf16* Qh, const bf16* Kh, const bf16* Vh, bf16* Yh, int q0, LAS unsigned char* vl, LAS float* sc, int lane) {
    constexpr int D = 128; constexpr float C1 = 0.08838834764831845f * LOG2E;
    const int n = lane & 31, h = lane >> 5;
    bf16x8 qf[8]; load_q<D>(qf, Qh, INW, q0, lane);
    bf16x8 kf[8];
    float m = -INFINITY;
    for (int k0 = 0; k0 < MEML; k0 += 32) {
        load_k<D>(kf, Kh, DM, k0, lane);
        const f32x16 S = qk<D>(kf, qf);
#pragma unroll
        for (int i = 0; i < 16; ++i) m = fmaxf(m, S[i]);
    }
    m = fmaxf(m, xhalf(m)) * C1;
    f32x16 o[4];
#pragma unroll
    for (int i = 0; i < 16; ++i) { o[0][i] = 0.f; o[1][i] = 0.f; o[2][i] = 0.f; o[3][i] = 0.f; }
    float l = 0.f; v4u vr[8];
    for (int k0 = 0; k0 < MEML; k0 += 32) {
        load_k<D>(kf, Kh, DM, k0, lane); load_v<D>(vr, Vh, DM, k0, lane);
        const f32x16 S = qk<D>(kf, qf);
        store_v<D>(vr, vl, lane);
        float a[16];
#pragma unroll
        for (int i = 0; i < 16; ++i) { a[i] = __builtin_amdgcn_exp2f(S[i] * C1 - m); l += a[i]; }
        bf16x8 pa[2]; pack_p(pa, a);
        pv<D>(o, pa, vl, lane);
    }
    l += xhalf(l);
    if (h == 0) sc[n] = 1.0f / l;
    LDS_WAIT();
    store_o<D>(o, Yh, INW, q0, lane, sc);
    LDS_WAIT();
    (void)n;
}
}

__device__ __forceinline__ void phase_attention(Frame& F) {
    const int c = (int)blockIdx.x, lane = F.lane;
    const int myid = ((((c >> 3) * NWAVES) + F.wave) << 3) | (c & 7);
    LAS unsigned char* vl = F.lds + at::LDS_V + F.wave * 8192;
    LAS float* sc = (LAS float*)(F.lds + at::LDS_SC) + F.wave * 64;
    LAS float* tb = (LAS float*)(F.lds + at::LDS_TB);
    for (int i = F.tid; i < 8 * at::TB_N; i += NWAVES * 64) { const int hq = i / at::TB_N, dist = i % at::TB_N - 32; tb[i] = (dist >= 0 && dist < 128) ? F.BIAS[dist * 8 + hq] * at::LOG2E : 0.f; }
    __syncthreads();
#if ATTN_MFMA_SB
    for (int t = myid; t < 128 * 32; t += F.ngw) {
        const int x = t & 7, rest = t >> 3, pp = rest >> 5, j = rest & 31, pair = x + 8 * pp, b = pair >> 3, h = pair & 7;
        const bf16* base = F.PROJ + (size_t)b * SEQ * INW + h * 64;
        at::sb_block(base + C_QB, base + C_KB, base + C_VB, (bf16*)base + C_QB, 32 * (63 - j), vl, lane);
        at::sb_block(base + C_QB, base + C_KB, base + C_VB, (bf16*)base + C_QB, 32 * j, vl, lane);
    }
#else
    for (int it = F.gw; it < T * 8; it += F.ngw) attn_sb_row(F, it >> 3, it & 7);
#endif
#if ATTN_MFMA_MEM
    for (int t = myid; t < 64 * 64; t += F.ngw) {
        const int x = t & 7, rest = t >> 3, pp = rest >> 6, qb = rest & 63, pair = x + 8 * pp, b = pair >> 2, h = pair & 3;
        const bf16* qbase = F.PROJ + (size_t)b * SEQ * INW + C_QM + h * 128; const bf16* kbase = F.MKV + (size_t)b * MEML * DM + h * 128;
        at::mem_block(qbase, kbase, kbase + 512, (bf16*)qbase, 32 * qb, vl, sc, lane);
    }
#else
    for (int it = F.gw; it < T * 4; it += F.ngw) attn_mem_row(F, it >> 2, it & 3);
#endif
#if ATTN_MFMA_SWA
    for (int t = myid; t < 32 * 256; t += F.ngw) {
        const int x = t & 7, rest = t >> 3, pi = rest >> 8, w = rest & 255, g = w >> 6, qb = w & 63, pair = x + 8 * pi, b = pair >> 1, kvh = pair & 1, hq = kvh * 4 + g;
        const bf16* base = F.PROJ + (size_t)b * SEQ * INW;
        at::swa_block(base + C_QA + hq * 64, base + C_KA + kvh * 64, base + C_VA + kvh * 64, (bf16*)base + C_QA + hq * 64, 32 * qb, F.sinks[hq] * at::LOG2E, tb + hq * at::TB_N, vl, sc, lane);
    }
#else
    for (int it = F.gw; it < T * 8; it += F.ngw) attn_swa_row(F, it >> 3, it & 7);
#endif
}

__device__ __forceinline__ void phase_norm1(Frame& F) {
    for (int m = F.gw; m < T; m += F.ngw) {
        const f32x4* mr = (const f32x4*)(F.MIX + (size_t)m * DM) + F.lane; const f32x4* xr = (const f32x4*)(F.x + (size_t)m * DM) + F.lane;
        const f32x4* g1 = (const f32x4*)F.ln_mix_post + F.lane; const f32x4* g2 = (const f32x4*)F.ln_ffn_pre + F.lane;
        f32x4 v[4]; float s = 0.f;
#pragma unroll
        for (int j = 0; j < 4; ++j) { v[j] = mr[64 * j]; s += (v[j].x * v[j].x + v[j].y * v[j].y) + (v[j].z * v[j].z + v[j].w * v[j].w); }
        const float rstd = 1.0f / sqrtf(wave_sum(s) * (1.f / DM) + EPS);
        float s2 = 0.f; f32x4* orow = (f32x4*)(F.out + (size_t)m * DM) + F.lane;
#pragma unroll
        for (int j = 0; j < 4; ++j) { v[j] = xr[64 * j] + v[j] * rstd * g1[64 * j]; orow[64 * j] = v[j]; s2 += (v[j].x * v[j].x + v[j].y * v[j].y) + (v[j].z * v[j].z + v[j].w * v[j].w); }
        const float rstd2 = 1.0f / sqrtf(wave_sum(s2) * (1.f / DM) + EPS);
        v2u* o8 = (v2u*)(F.XN2 + (size_t)m * DM) + F.lane;
#pragma unroll
        for (int j = 0; j < 4; ++j) { const f32x4 gg = g2[64 * j]; v2u w; w.x = pk2(v[j].x * rstd2 * gg.x, v[j].y * rstd2 * gg.y); w.y = pk2(v[j].z * rstd2 * gg.z, v[j].w * rstd2 * gg.w); o8[64 * j] = w; }
    }
}
__device__ __forceinline__ void phase_norm2(Frame& F) {
    for (int m = F.gw; m < T; m += F.ngw) {
        const f32x4* fr = (const f32x4*)(F.MIX + (size_t)m * DM) + F.lane; f32x4* orow = (f32x4*)(F.out + (size_t)m * DM) + F.lane;
        const f32x4* g1 = (const f32x4*)F.ln_ffn_post + F.lane;
        f32x4 v[4]; float s = 0.f;
#pragma unroll
        for (int j = 0; j < 4; ++j) { v[j] = fr[64 * j]; s += (v[j].x * v[j].x + v[j].y * v[j].y) + (v[j].z * v[j].z + v[j].w * v[j].w); }
        const float rstd = 1.0f / sqrtf(wave_sum(s) * (1.f / DM) + EPS);
#pragma unroll
        for (int j = 0; j < 4; ++j) orow[64 * j] = orow[64 * j] + v[j] * rstd * g1[64 * j];
    }
}

#define XB_TMO      128
#define XB_XCNT(j)  (256  + 64 * (j))
#define XB_XSUB(j)  (1280 + 64 * (j))
#define XB_XGEN(j)  (2304 + 64 * (j))
#define XB_TOP      3328
#define XB_TOPGEN   3392
#define XCD_BAR_WORDS 3456
#define XB_SPIN_CAP (1u << 18)
__device__ __forceinline__ unsigned xb_ld(unsigned* p)              { return __hip_atomic_load(p, __ATOMIC_RELAXED, __HIP_MEMORY_SCOPE_AGENT); }
__device__ __forceinline__ unsigned xb_add(unsigned* p, unsigned v) { return __hip_atomic_fetch_add(p, v, __ATOMIC_RELAXED, __HIP_MEMORY_SCOPE_AGENT); }
__device__ __forceinline__ unsigned xb_xcc_id() { return (unsigned)__builtin_amdgcn_s_getreg((3 << 11) | 20) & 0xFu; }
#define XB_SPIN(cond, bar) do { unsigned _sp = 0; while (cond) { __builtin_amdgcn_s_sleep(1); \
    if ((++_sp & 255u) == 0u) { if (xb_ld(&(bar)[XB_TMO])) break; if (_sp > XB_SPIN_CAP) { atomicAdd(&(bar)[XB_TMO], 1u); break; } } } } while (0)
struct XcdBarrier { unsigned* bar; unsigned x; volatile LAS unsigned* st; };
__device__ __forceinline__ XcdBarrier xcd_barrier_post(unsigned* bar, volatile LAS unsigned* st) {
    XcdBarrier b; b.bar = bar; b.x = xb_xcc_id(); b.st = st;
    if (threadIdx.x == 0) (void)xb_add(&bar[XB_XCNT(b.x)], 1u);
    return b;
}
__device__ __forceinline__ void xcd_barrier_complete(unsigned* bar, unsigned x, unsigned& nloc, unsigned& nx) {
    const unsigned G = gridDim.x * gridDim.y * gridDim.z;
    unsigned sum, cnt, mine, sp = 0u;
    for (;;) {
        sum = 0u; cnt = 0u; mine = 0u;
#pragma unroll
        for (unsigned j = 0; j < 16; ++j) { const unsigned c = xb_ld(&bar[XB_XCNT(j)]); sum += c; cnt += (c > 0u) ? 1u : 0u; mine = (j == x) ? c : mine; }
        if (sum == G) break;
        __builtin_amdgcn_s_sleep(1);
        if ((++sp & 255u) == 0u) { if (xb_ld(&bar[XB_TMO])) break; if (sp > XB_SPIN_CAP) { atomicAdd(&bar[XB_TMO], 1u); break; } }
    }
    nloc = mine > 0u ? mine : 1u; nx = cnt > 0u ? cnt : 1u;
}
__device__ __forceinline__ void xcd_barrier(const XcdBarrier& b) {
    asm volatile("s_waitcnt vmcnt(0)" ::: "memory");
    __syncthreads();
    if (threadIdx.x == 0) {
        unsigned* bar = b.bar;
        __builtin_amdgcn_s_waitcnt(0);
        unsigned nloc = b.st[0], nx = b.st[1];
        if (nloc == 0u) { xcd_barrier_complete(bar, b.x, nloc, nx); b.st[0] = nloc; b.st[1] = nx; }
        const unsigned old = xb_add(&bar[XB_XSUB(b.x)], 1u);
        const unsigned gen = old / nloc;
        if (old + 1u == (gen + 1u) * nloc) {
            __builtin_amdgcn_fence(__ATOMIC_RELEASE, "agent");
            asm volatile("s_waitcnt vmcnt(0)" ::: "memory");
            const unsigned og = xb_add(&bar[XB_TOP], 1u);
            const unsigned tg = og / nx;
            if (og + 1u == (tg + 1u) * nx) xb_add(&bar[XB_TOPGEN], 1u);
            else XB_SPIN(xb_ld(&bar[XB_TOPGEN]) == tg, bar);
            __builtin_amdgcn_fence(__ATOMIC_ACQUIRE, "agent");
            xb_add(&bar[XB_XGEN(b.x)], 1u);
            asm volatile("s_waitcnt vmcnt(0)" ::: "memory");
        } else {
            XB_SPIN(xb_ld(&bar[XB_XGEN(b.x)]) == gen, bar);
            __builtin_amdgcn_fence(__ATOMIC_ACQUIRE, "agent");
            asm volatile("s_waitcnt vmcnt(0)" ::: "memory");
        }
    }
    __syncthreads();
}

struct Args { const float* in[18]; float* out; unsigned char* ws; int ph_lo, ph_hi, coop_probe, pad; };
__global__ void __launch_bounds__(NWAVES * 64, 2) mk_fwd(Args args) {
    extern __shared__ __attribute__((aligned(16))) unsigned char lds[];
    Frame F;
    F.lds = (LAS unsigned char*)lds;
    F.tid = threadIdx.x; F.lane = F.tid & 63; F.wave = __builtin_amdgcn_readfirstlane(F.tid >> 6);
    F.G = gridDim.x; F.gw = blockIdx.x * NWAVES + F.wave; F.ngw = F.G * NWAVES;
    unsigned char* ws = args.ws;
    F.x = args.in[0]; F.mem = args.in[1]; F.ln_mix_pre = args.in[2]; F.ln_mix_post = args.in[3]; F.w_in = args.in[4]; F.sinks = args.in[5]; F.rel_bias = args.in[6]; F.ln_mem = args.in[7];
    F.w_mem_kv = args.in[8]; F.w_br0 = args.in[9]; F.w_br1 = args.in[10]; F.w_br2 = args.in[11]; F.w_out = args.in[12]; F.ln_ffn_pre = args.in[13]; F.ln_ffn_post = args.in[14];
    F.w_gate = args.in[15]; F.w_up = args.in[16]; F.w_down = args.in[17]; F.out = args.out;
    F.WinT = (bf16*)(ws + WS_WIN); F.WmkvT = (bf16*)(ws + WS_WMKV); F.WbrT = (bf16*)(ws + WS_WBR); F.WoutT = (bf16*)(ws + WS_WOUT); F.WguT = (bf16*)(ws + WS_WGU); F.WdnT = (bf16*)(ws + WS_WDN);
    F.BIAS = (float*)(ws + WS_BIAS); F.MN = (bf16*)(ws + WS_MN); F.MKV = (bf16*)(ws + WS_MKV); F.XN = (bf16*)(ws + WS_XN); F.MERGED = (bf16*)(ws + WS_XN); F.PROJ = (bf16*)(ws + WS_PROJ);
    F.MIX = (float*)(ws + WS_MIX); F.XN2 = (bf16*)(ws + WS_XN2); F.AH = (bf16*)(ws + WS_A);
    const int lo = args.ph_lo, hi = args.ph_hi;
    volatile LAS unsigned* MISC = (volatile LAS unsigned*)(F.lds + LDS_MISC);
    if (F.tid < 16) MISC[F.tid] = 0u;
    __syncthreads();
    XcdBarrier bar = xcd_barrier_post((unsigned*)(ws + WS_CTL) + CW_BAR, MISC + 8);
    if (args.coop_probe) cg::this_grid().sync();
#define IN(k) (lo <= (k) && (k) < hi)
#define SEAM(k) do { if (IN(k) && IN((k) + 1)) { xcd_barrier(bar); } } while (0)
    const int c = (int)blockIdx.x;

    if (IN(0)) { phase_prologue(F); }
    SEAM(0);
    if (IN(1)) {
        pg8::Gemm g{DM, DM, DM}; SchedProj S{F.G, c, (const char*)F.XN, (const char*)F.MN, (const char*)F.WinT, (const char*)F.WmkvT}; EpiProj E{F.PROJ, F.MKV};
        pg8::gemm_phase<EpiProj, SchedProj, true, true>(F.lds, g, S, E);
    }
    SEAM(1);
    if (IN(2)) { phase_attention(F); }
    SEAM(2);
    if (IN(3)) {
        pg8::Gemm g{INW, 512, 512}; SchedMerge S{F.G, c, (const char*)F.PROJ, (const char*)F.WbrT}; EpiMerge E{F.PROJ, F.MERGED};
        pg8::gemm_phase<EpiMerge, SchedMerge, true, true>(F.lds, g, S, E);
    }
    SEAM(3);
    if (IN(4)) {
        pg8::Gemm g{DM, DM, DM}; SchedPlain S{F.G, c, T / 256, DM / 256, (const char*)F.MERGED, (const char*)F.WoutT, (size_t)256 * DM * 2, (size_t)256 * DM * 2}; EpiF32 E{F.MIX, DM};
        pg8::gemm_phase<EpiF32, SchedPlain, true, true>(F.lds, g, S, E);
    }
    SEAM(4);
    if (IN(5)) { phase_norm1(F); }
    SEAM(5);
    if (IN(6)) {
        pg8::Gemm g{DM, DM, DM}; SchedPlain S{F.G, c, T / 256, NGU / 256, (const char*)F.XN2, (const char*)F.WguT, (size_t)256 * DM * 2, (size_t)256 * DM * 2}; EpiSwiGLU E{F.AH};
        pg8::gemm_phase<EpiSwiGLU, SchedPlain, true, true>(F.lds, g, S, E);
    }
    SEAM(6);
    if (IN(7)) {
        pg8::Gemm g{DFF, DFF, DFF}; SchedPlain S{F.G, c, T / 256, DM / 256, (const char*)F.AH, (const char*)F.WdnT, (size_t)256 * DFF * 2, (size_t)256 * DFF * 2}; EpiF32 E{F.MIX, DM};
        pg8::gemm_phase<EpiF32, SchedPlain, true, true>(F.lds, g, S, E);
    }
    SEAM(7);
    if (IN(8)) { phase_norm2(F); }
#undef IN
#undef SEAM
}

extern "C" void kernel_launch(void* const* d_in, const int* in_sizes, int n_in, void* d_out, int out_size, void* d_ws, size_t ws_size, hipStream_t stream) {
    static int grid = 0;
    if (grid == 0) {
        if (n_in != 18 || in_sizes[0] != T * DM || out_size != T * DM || ws_size < WS_END) { fprintf(stderr, "kernel_launch: unexpected shapes: n_in %d in0 %d out %d ws %zu (need %zu)\n", n_in, n_in > 0 ? in_sizes[0] : -1, out_size, ws_size, (size_t)WS_END); grid = -1; return; }
        int dev = 0, cus = 0, per_cu = 0;
        if (hipGetDevice(&dev) != hipSuccess || hipDeviceGetAttribute(&cus, hipDeviceAttributeMultiprocessorCount, dev) != hipSuccess) { grid = -1; return; }
        if (hipFuncSetAttribute((const void*)mk_fwd, hipFuncAttributeMaxDynamicSharedMemorySize, LDS_BYTES) != hipSuccess) { fprintf(stderr, "kernel_launch: hipFuncSetAttribute failed\n"); grid = -1; return; }
        if (hipOccupancyMaxActiveBlocksPerMultiprocessor(&per_cu, (const void*)mk_fwd, NWAVES * 64, LDS_BYTES) != hipSuccess || per_cu < 1) { fprintf(stderr, "kernel_launch: occupancy query says %d\n", per_cu); per_cu = 1; }
        (void)hipGetLastError();
        grid = cus;
    }
    if (grid < 0) return;
    if (hipMemsetAsync((char*)d_ws + WS_CTL, 0, CTL_ZERO_BYTES, stream) != hipSuccess) { fprintf(stderr, "kernel_launch: hipMemsetAsync failed\n"); return; }
    Args a{};
    for (int i = 0; i < 18; ++i) a.in[i] = (const float*)d_in[i];
    a.out = (float*)d_out; a.ws = (unsigned char*)d_ws;
#if MK_N_LAUNCHES == 1
    a.ph_lo = 0; a.ph_hi = N_PHASES;
    void* kargs[] = {&a};
    hipError_t e = hipLaunchCooperativeKernel((const void*)mk_fwd, dim3(grid), dim3(NWAVES * 64), kargs, LDS_BYTES, stream);
    if (e != hipSuccess) fprintf(stderr, "kernel_launch: cooperative launch failed: %s (grid %d)\n", hipGetErrorString(e), grid);
#else
#ifndef PROBE_SEQ
#define PROBE_SEQ 0, 1, 2, 3, 4, 5, 6, 7, 8
#endif
    static const int seq[] = {PROBE_SEQ};
    for (unsigned i = 0; i < sizeof(seq) / sizeof(seq[0]); ++i) {
        a.ph_lo = seq[i]; a.ph_hi = seq[i] + 1;
        hipLaunchKernelGGL(mk_fwd, dim3(grid), dim3(NWAVES * 64), LDS_BYTES, stream, a);
    }
#endif
}
```
